# Optimizing an MI355X kernel written in HIP

```python
import math
import jax, jax.numpy as jnp
from jax import lax
import numpy as np

D_MODEL = 2048
BATCH = 4
SEQ = 2048
DEPTH = 1

GRID_W = 64
ROPE_THETA = 10000.0
Q_BLOCK = 128
EPS = 1e-6

HEAD_DIM = 128
HA = 8
HKV = 2
G_A = HA // HKV

HB = 8
QK_NOPE = 128
QK_ROPE = 64
V_DIM = 128
KV_RANK = 512
QK_B = QK_NOPE + QK_ROPE

W_QA = HA * HEAD_DIM
W_KA = HKV * HEAD_DIM
W_VA = HKV * HEAD_DIM
W_QB = HB * QK_B
W_CKV = KV_RANK
W_KPE = QK_ROPE
W_IN = W_QA + W_KA + W_VA + W_QB + W_CKV + W_KPE

MIX_A = HA * HEAD_DIM
MIX_B = HB * V_DIM
MIX_W = MIX_A + MIX_B

D_FF = 4 * D_MODEL
N_MOD = 6

kernel_name = "hybrid_gqa_mla_axialrope_block"


def rms_norm(x, g):
    xf = x.astype(jnp.float32)
    y = xf * lax.rsqrt(jnp.mean(xf * xf, axis=-1, keepdims=True) + EPS)
    return (y * g.astype(jnp.float32)).astype(x.dtype)


def rope_tables_2d(seq_len, dim):
    rows = seq_len // GRID_W
    r, cl = jnp.meshgrid(jnp.arange(rows), jnp.arange(GRID_W), indexing="ij")
    row = r.reshape(-1).astype(jnp.float32)
    col = cl.reshape(-1).astype(jnp.float32)
    half = dim // 2
    inv = ROPE_THETA ** (-jnp.arange(0, half, 2, dtype=jnp.float32) / half)
    ang_r = row[:, None] * inv[None, :]
    ang_c = col[:, None] * inv[None, :]
    ang = jnp.concatenate([ang_r, ang_r, ang_c, ang_c], axis=-1)
    return jnp.cos(ang), jnp.sin(ang)


def _rotate_half(v):
    h = v.shape[-1] // 2
    return jnp.concatenate([-v[..., h:], v[..., :h]], axis=-1)


def apply_rope_2d(x, cos, sin):
    half = x.shape[-1] // 2
    rot = jnp.concatenate([_rotate_half(x[..., :half]), _rotate_half(x[..., half:])], axis=-1)
    return (x.astype(jnp.float32) * cos + rot.astype(jnp.float32) * sin).astype(x.dtype)


def gqa_blocked(q, k, v):
    B, _, _, S, D = q.shape
    scale = 1.0 / math.sqrt(D)

    def block(i):
        qb = lax.dynamic_slice_in_dim(q, i * Q_BLOCK, Q_BLOCK, axis=3)
        s = jnp.einsum("bkgqd,bksd->bkgqs", qb, k).astype(jnp.float32) * scale
        p = jax.nn.softmax(s, axis=-1).astype(v.dtype)
        return jnp.einsum("bkgqs,bksd->bkgqd", p, v)

    o = lax.map(block, jnp.arange(S // Q_BLOCK))
    o = jnp.transpose(o, (1, 0, 4, 2, 3, 5))
    return o.reshape(B, S, HA * D)


def mla_blocked(q_nope, q_pe, k_nope, k_pe, v):
    B, H, S, _ = q_nope.shape
    scale = 1.0 / math.sqrt(QK_B)

    def block(i):
        qn = lax.dynamic_slice_in_dim(q_nope, i * Q_BLOCK, Q_BLOCK, axis=2)
        qp = lax.dynamic_slice_in_dim(q_pe, i * Q_BLOCK, Q_BLOCK, axis=2)
        s = (jnp.einsum("bhqd,bhsd->bhqs", qn, k_nope)
             + jnp.einsum("bhqr,bsr->bhqs", qp, k_pe)).astype(jnp.float32) * scale
        p = jax.nn.softmax(s, axis=-1).astype(v.dtype)
        return jnp.einsum("bhqs,bhsd->bhqd", p, v)

    o = lax.map(block, jnp.arange(S // Q_BLOCK))
    o = jnp.transpose(o, (1, 0, 3, 2, 4))
    return o.reshape(B, S, H * V_DIM)


def setup_inputs(seed: int = 0) -> dict:
    key = jax.random.key(seed)
    ks = jax.random.split(key, 20)
    f = jnp.float32

    def w(k, shape, fan_in):
        return jax.random.normal(k, shape, f) * (fan_in ** -0.5)

    def gain(k, shape):
        return 1.0 + 0.05 * jax.random.normal(k, shape, f)

    L = DEPTH
    return {
        "x": jax.random.normal(ks[0], (BATCH, SEQ, D_MODEL), f),
        "c": jax.random.normal(ks[1], (BATCH, D_MODEL), f),
        "w_ada": w(ks[2], (L, D_MODEL, N_MOD * D_MODEL), D_MODEL),
        "b_ada": 0.02 * jax.random.normal(ks[3], (L, N_MOD * D_MODEL), f),
        "g_pre_attn": gain(ks[4], (L, D_MODEL)),
        "w_in": w(ks[5], (L, D_MODEL, W_IN), D_MODEL),
        "g_q_a": gain(ks[6], (L, HEAD_DIM)),
        "g_k_a": gain(ks[7], (L, HEAD_DIM)),
        "g_ckv": gain(ks[8], (L, KV_RANK)),
        "w_kv_b": w(ks[9], (L, KV_RANK, HB * (QK_NOPE + V_DIM)), KV_RANK),
        "g_out_a": gain(ks[10], (L, MIX_A)),
        "g_out_b": gain(ks[11], (L, MIX_B)),
        "w_out": w(ks[12], (L, MIX_W, D_MODEL), MIX_W),
        "g_post_attn": gain(ks[13], (L, D_MODEL)),
        "g_pre_mlp": gain(ks[14], (L, D_MODEL)),
        "w_mlp_in": w(ks[15], (L, D_MODEL, D_FF), D_MODEL),
        "w_mlp_out": w(ks[16], (L, D_FF, D_MODEL), D_FF),
        "g_post_mlp": gain(ks[17], (L, D_MODEL)),
    }


def reference(x, c, w_ada, b_ada, g_pre_attn, w_in, g_q_a, g_k_a, g_ckv, w_kv_b,
              g_out_a, g_out_b, w_out, g_post_attn, g_pre_mlp, w_mlp_in, w_mlp_out,
              g_post_mlp):
    B, S, _ = x.shape
    cos_a, sin_a = rope_tables_2d(S, HEAD_DIM)
    cos_b, sin_b = rope_tables_2d(S, QK_ROPE)
    c_act = jax.nn.silu(c)

    offs = np.cumsum([0, W_QA, W_KA, W_VA, W_QB, W_CKV, W_KPE])

    for l in range(DEPTH):
        mod = c_act @ w_ada[l] + b_ada[l]
        sh_a, sc_a, gt_a, sh_m, sc_m, gt_m = [m[:, None, :] for m in jnp.split(mod, N_MOD, axis=-1)]

        h = rms_norm(x, g_pre_attn[l]) * (1.0 + sc_a) + sh_a
        proj = h @ w_in[l]
        q_a, k_a, v_a, q_b, ckv, k_pe = [proj[..., offs[i]:offs[i + 1]] for i in range(6)]

        q_a = rms_norm(q_a.reshape(B, S, HA, HEAD_DIM), g_q_a[l]).transpose(0, 2, 1, 3)
        k_a = rms_norm(k_a.reshape(B, S, HKV, HEAD_DIM), g_k_a[l]).transpose(0, 2, 1, 3)
        v_a = v_a.reshape(B, S, HKV, HEAD_DIM).transpose(0, 2, 1, 3)
        q_a = apply_rope_2d(q_a, cos_a, sin_a).reshape(B, HKV, G_A, S, HEAD_DIM)
        k_a = apply_rope_2d(k_a, cos_a, sin_a)
        o_a = gqa_blocked(q_a, k_a, v_a)

        q_b = q_b.reshape(B, S, HB, QK_B).transpose(0, 2, 1, 3)
        q_nope = q_b[..., :QK_NOPE]
        q_pe = apply_rope_2d(q_b[..., QK_NOPE:], cos_b, sin_b)
        kv = rms_norm(ckv, g_ckv[l]) @ w_kv_b[l]
        kv = kv.reshape(B, S, HB, QK_NOPE + V_DIM).transpose(0, 2, 1, 3)
        k_nope, v_b = kv[..., :QK_NOPE], kv[..., QK_NOPE:]
        k_pe = apply_rope_2d(k_pe, cos_b, sin_b)
        o_b = mla_blocked(q_nope, q_pe, k_nope, k_pe, v_b)

        o = jnp.concatenate([rms_norm(o_a, g_out_a[l]), rms_norm(o_b, g_out_b[l])], axis=-1)
        o = o @ w_out[l]
        x = x + gt_a * rms_norm(o, g_post_attn[l])

        h = rms_norm(x, g_pre_mlp[l]) * (1.0 + sc_m) + sh_m
        y = jnp.square(jax.nn.relu(h @ w_mlp_in[l])) @ w_mlp_out[l]
        x = x + gt_m * rms_norm(y, g_post_mlp[l])

    return x
```

```cpp
#include <hip/hip_runtime.h>
#include <hip/hip_cooperative_groups.h>
#include <cstdio>
#include <cstdint>
namespace cg = cooperative_groups;

#ifndef MK_N_LAUNCHES
#define MK_N_LAUNCHES 1
#endif
#ifndef MK_CG_ALL
#define MK_CG_ALL 1
#endif

namespace pg8 {
#define PG8_LAS __attribute__((address_space(3)))
typedef unsigned short bf16_t;
typedef short bf16x8 __attribute__((ext_vector_type(8)));
typedef float f32x4 __attribute__((ext_vector_type(4)));
typedef unsigned u32x4 __attribute__((ext_vector_type(4)));
constexpr int BM = 256, BK = 64, HALF = 128, HTB = HALF * BK * 2, STAGE_BYTES = 8 * HTB, NXCD = 8, WGM = 8;

__host__ __device__ __forceinline__ int lds_byte(int r, int c) { const int st = (r >> 4) * 2 + (c >> 5), rr = r & 15, cc = c & 31, ob = rr * 64 + cc * 2; return st * 1024 + (ob ^ (((ob >> 9) & 1) << 5)); }
__host__ __device__ __forceinline__ void stage_rc(int b, int& R, int& C) { const int st = b / 1024, sb = b % 1024, swz = sb ^ (((sb >> 9) & 1) << 5); R = (st >> 1) * 16 + swz / 64; C = (st & 1) * 32 + (swz % 64) / 2; }
__host__ __device__ __forceinline__ int perm32(int rho) { const int n = rho >> 4, i = rho & 15; return 8 * (i >> 2) + 4 * n + (i & 3); }

struct Unit { int pm, pn; };
struct Gemm { const bf16_t* A; const bf16_t* Bt; int M, N, K; };

struct StaticOrder {
    int nM, nN, nwg, G, c;
    __host__ __device__ void init(int M, int N, int G_, int c_) { nM = M / BM; nN = N / BM; nwg = nM * nN; G = G_; c = c_; }
    __host__ __device__ bool next(int i, Unit& u) const {
        const long L = (long)i * G + c; if (L >= nwg) return false;
        int wgid = (int)L; { const int q = nwg / NXCD, r = nwg % NXCD, xcd = wgid % NXCD, off = wgid / NXCD; wgid = (xcd < r ? xcd * (q + 1) : r * (q + 1) + (xcd - r) * q) + off; }
        const int nig = WGM * nN, gid = wgid / nig, fm = gid * WGM, gsz = (nM - fm) < WGM ? (nM - fm) : WGM;
        u.pm = fm + ((wgid % nig) % gsz); u.pn = (wgid % nig) / gsz; return true;
    }
    __device__ __forceinline__ void a_ready(const Unit&) const {}
    __device__ __forceinline__ void done(const Unit&) const {}
};

__device__ __forceinline__ unsigned cvt_pk_bf16(float lo, float hi) { unsigned r; asm volatile("v_cvt_pk_bf16_f32 %0, %1, %2" : "=v"(r) : "v"(lo), "v"(hi)); return r;  }
__device__ __forceinline__ u32x4 pack8(f32x4 v0, f32x4 v1) { u32x4 w; w.x = cvt_pk_bf16(v0[0], v0[1]); w.y = cvt_pk_bf16(v0[2], v0[3]); w.z = cvt_pk_bf16(v1[0], v1[1]); w.w = cvt_pk_bf16(v1[2], v1[3]); return w; }
__device__ __forceinline__ float sq8(f32x4 a, f32x4 b) { return ((a[0] * a[0] + a[1] * a[1]) + (a[2] * a[2] + a[3] * a[3])) + ((b[0] * b[0] + b[1] * b[1]) + (b[2] * b[2] + b[3] * b[3])); }

struct EpiProj {
    static constexpr bool PERM = true, AFTER_DRAIN = false, MIDK = false;
    bf16_t *QA, *KA, *VA, *QB, *CKV, *KPE; float* ssq;
    __device__ __forceinline__ void midk(f32x4 (&)[2][2][4][2], int, int, PG8_LAS unsigned char*) const {}
    __device__ __forceinline__ void operator()(const f32x4 (&acc)[2][2][4][2], const Unit& u, int wr, int wc, int fr, int fq, PG8_LAS unsigned char*) const {
        const int pn = u.pn; bf16_t* base; int ldc, colt;
        if (pn < 4) { base = QA; ldc = 1024; colt = pn * 256; }
        else if (pn == 4) { base = KA; ldc = 256; colt = 0; }
        else if (pn == 5) { base = VA; ldc = 256; colt = 0; }
        else if (pn < 12) { base = QB; ldc = 1536; colt = (pn - 6) * 256; }
        else if (pn < 14) { base = CKV; ldc = 512; colt = (pn - 12) * 256; }
        else { base = KPE; ldc = 64; colt = 0; }
        const int row0 = u.pm * BM + wr * 64 + fr, lc0 = wc * 32 + 8 * fq;
        const bool kpe = (pn == 14), st0 = !kpe || (lc0 < 64), st1 = !kpe;
#pragma unroll
        for (int ai = 0; ai < 2; ++ai)
#pragma unroll
            for (int m = 0; m < 4; ++m) { const int row = row0 + ai * HALF + m * 16; bf16_t* rowp = base + (size_t)row * ldc + colt + lc0;
                if (st0) *(u32x4*)(rowp) = pack8(acc[ai][0][m][0], acc[ai][0][m][1]);
                if (st1) *(u32x4*)(rowp + HALF) = pack8(acc[ai][1][m][0], acc[ai][1][m][1]);
                if (pn == 12 || pn == 13) { float s = sq8(acc[ai][0][m][0], acc[ai][0][m][1]) + sq8(acc[ai][1][m][0], acc[ai][1][m][1]);
                    s += __shfl_xor(s, 16); s += __shfl_xor(s, 32);
                    if (fq == 0) ssq[(size_t)row * 8 + (pn - 12) * 4 + wc] = s; } }
    }
};
struct EpiKvb {
    static constexpr bool PERM = true, AFTER_DRAIN = false, MIDK = false;
    bf16_t* O; const float* ssq;
    __device__ __forceinline__ void midk(f32x4 (&)[2][2][4][2], int, int, PG8_LAS unsigned char*) const {}
    __device__ __forceinline__ void operator()(const f32x4 (&acc)[2][2][4][2], const Unit& u, int wr, int wc, int fr, int fq, PG8_LAS unsigned char*) const {
        const int row0 = u.pm * BM + wr * 64 + fr, col0 = u.pn * BM + wc * 32 + 8 * fq;
#pragma unroll
        for (int ai = 0; ai < 2; ++ai)
#pragma unroll
            for (int m = 0; m < 4; ++m) { const int row = row0 + ai * HALF + m * 16;
                const f32x4 a = *(const f32x4*)(ssq + (size_t)row * 8), b = *(const f32x4*)(ssq + (size_t)row * 8 + 4);
                const float inv = 1.0f / sqrtf((((a[0] + a[1]) + (a[2] + a[3])) + ((b[0] + b[1]) + (b[2] + b[3]))) * (1.0f / 512.0f) + 1e-6f);
                bf16_t* rowp = O + (size_t)row * 2048 + col0;
                *(u32x4*)(rowp) = pack8(acc[ai][0][m][0] * inv, acc[ai][0][m][1] * inv);
                *(u32x4*)(rowp + HALF) = pack8(acc[ai][1][m][0] * inv, acc[ai][1][m][1] * inv); }
    }
};
template <int ACT  , bool ROWSCALE, bool SSQ> struct EpiGen {
    static constexpr bool PERM = true, AFTER_DRAIN = false, MIDK = ROWSCALE;
    bf16_t* O; int ldc; float* ssq;
    int nssq;
    __device__ __forceinline__ void midk(f32x4 (&acc)[2][2][4][2], int wr, int fr, PG8_LAS unsigned char* tab) const {
        if constexpr (ROWSCALE) {
            const PG8_LAS float* T = (const PG8_LAS float*)tab;
#pragma unroll
            for (int ai = 0; ai < 2; ++ai)
#pragma unroll
                for (int m = 0; m < 4; ++m) { const float r = T[ai * HALF + wr * 64 + m * 16 + fr];
#pragma unroll
                    for (int bj = 0; bj < 2; ++bj)
#pragma unroll
                        for (int n = 0; n < 2; ++n) acc[ai][bj][m][n] = acc[ai][bj][m][n] * r; }
        }
    }
    __device__ __forceinline__ void operator()(const f32x4 (&acc)[2][2][4][2], const Unit& u, int wr, int wc, int fr, int fq, PG8_LAS unsigned char* tab) const {
        const int row0 = u.pm * BM + wr * 64 + fr, col0 = u.pn * BM + wc * 32 + 8 * fq;
        const PG8_LAS float* T = (const PG8_LAS float*)tab;
#pragma unroll
        for (int ai = 0; ai < 2; ++ai)
#pragma unroll
            for (int m = 0; m < 4; ++m) { const int row = row0 + ai * HALF + m * 16;
                float sc = 1.0f; if constexpr (ROWSCALE) sc = T[256 + ai * HALF + wr * 64 + m * 16 + fr];
                f32x4 v[2][2];
#pragma unroll
                for (int bj = 0; bj < 2; ++bj)
#pragma unroll
                    for (int n = 0; n < 2; ++n) { f32x4 x = acc[ai][bj][m][n];
                        if constexpr (ROWSCALE) x = x * sc;
                        if constexpr (ACT == 1) { x[0] = fmaxf(x[0], 0.f); x[1] = fmaxf(x[1], 0.f); x[2] = fmaxf(x[2], 0.f); x[3] = fmaxf(x[3], 0.f); x = x * x; }
                        v[bj][n] = x; }
                bf16_t* rowp = O + (size_t)row * ldc + col0;
                *(u32x4*)(rowp) = pack8(v[0][0], v[0][1]);
                *(u32x4*)(rowp + HALF) = pack8(v[1][0], v[1][1]);
                if constexpr (SSQ) { float s = sq8(v[0][0], v[0][1]) + sq8(v[1][0], v[1][1]);
                    s += __shfl_xor(s, 16); s += __shfl_xor(s, 32);
                    if (fq == 0) ssq[(size_t)row * nssq + u.pn * 4 + wc] = s; } }
    }
};

template <class Epi, class Sched, bool ALIGN_EPI = false, bool SP2 = false>
__device__ __forceinline__ void gemm_phase(PG8_LAS unsigned char* lds, PG8_LAS unsigned char* tab, const Gemm g, const Sched& S, const Epi& E, const int tid, const int wid  ) {
    const int lane = tid & 63, wr = wid >> 2, wc = wid & 3, fr = lane & 15, fq = lane >> 4;
    const int K = g.K, nt = K / BK;
    unsigned voffA[2], voffB[2];
#pragma unroll
    for (int i = 0; i < 2; ++i) { int R, C; stage_rc(tid * 16 + i * 8192, R, C); const int Rb = Epi::PERM ? ((R & ~31) + perm32(R & 31)) : R;
        voffA[i] = (unsigned)(R * K + C) * 2u; voffB[i] = (unsigned)(Rb * K + C) * 2u; }
    const size_t kstep = (size_t)(BK * 2);
    const size_t hstep = (size_t)HALF * K * 2;
    const size_t tstep = 2 * hstep;
    const unsigned ldsw = (unsigned)wid * 1024u;
    const int aoff = lds_byte(wr * 64 + fr, fq * 8), boff = lds_byte(wc * 32 + fr, fq * 8);
#define PG8_SA(b, h) (((b) * 2 + (h)) * HTB)
#define PG8_SB(b, h) ((4 + (b) * 2 + (h)) * HTB)
#define PG8_STAGE(bufoff, gbase, voff) do { _Pragma("unroll") for (int _i = 0; _i < 2; ++_i) \
        __builtin_amdgcn_global_load_lds((const unsigned*)((const char*)(gbase) + (voff)[_i]), (PG8_LAS unsigned*)(lds + (bufoff) + ldsw + _i * 8192), 16, 0, 0); } while (0)
#define PG8_LDA(dst, b, h) do { _Pragma("unroll") for (int m = 0; m < 4; ++m) _Pragma("unroll") for (int k = 0; k < 2; ++k) dst[m][k] = *(const PG8_LAS bf16x8*)(lds + PG8_SA(b, h) + aoff + m * 2048 + k * 1024); } while (0)
#define PG8_LDB(dst, b, h) do { _Pragma("unroll") for (int n = 0; n < 2; ++n) _Pragma("unroll") for (int k = 0; k < 2; ++k) dst[n][k] = *(const PG8_LAS bf16x8*)(lds + PG8_SB(b, h) + boff + n * 2048 + k * 1024); } while (0)
#define PG8_MMA(ai, bj, At, Bt) do { __builtin_amdgcn_s_setprio(1); _Pragma("unroll") for (int m = 0; m < 4; ++m) _Pragma("unroll") for (int n = 0; n < 2; ++n) _Pragma("unroll") for (int k = 0; k < 2; ++k) \
        acc[ai][bj][m][n] = __builtin_amdgcn_mfma_f32_16x16x32_bf16(Bt[n][k], At[m][k], acc[ai][bj][m][n], 0, 0, 0); __builtin_amdgcn_s_setprio(0); } while (0)
#define PG8_WAIT_V(n) asm volatile("s_waitcnt vmcnt(" #n ")" ::: "memory")
#define PG8_WAIT_L(n) asm volatile("s_waitcnt lgkmcnt(" #n ")" ::: "memory")
#define PG8_BAR __builtin_amdgcn_s_barrier()
#define PG8_SCHED __builtin_amdgcn_sched_barrier(0)
    Unit cur, nxt; int ui = 0;
    if (!S.next(0, cur)) return;
    f32x4 acc[2][2][4][2];
#pragma unroll
    for (int a = 0; a < 2; ++a)
#pragma unroll
        for (int b = 0; b < 2; ++b)
#pragma unroll
            for (int m = 0; m < 4; ++m)
#pragma unroll
                for (int n = 0; n < 2; ++n) acc[a][b][m][n] = (f32x4){0.f, 0.f, 0.f, 0.f};
    bf16x8 At[4][2], B0[2][2], B1[2][2];
    const char* cA = (const char*)g.A + (size_t)cur.pm * tstep; const char* cB = (const char*)g.Bt + (size_t)cur.pn * tstep;
    S.a_ready(cur);
    if constexpr (SP2) {
        PG8_STAGE(PG8_SB(0, 0), cB, voffB); PG8_STAGE(PG8_SB(0, 1), cB + hstep, voffB); PG8_STAGE(PG8_SA(0, 0), cA, voffA); PG8_STAGE(PG8_SA(0, 1), cA + hstep, voffA);
        if (wr == 1) PG8_BAR;
        PG8_WAIT_V(2); PG8_BAR;
        PG8_STAGE(PG8_SB(1, 0), cB + kstep, voffB); PG8_STAGE(PG8_SA(1, 0), cA + kstep, voffA); PG8_STAGE(PG8_SB(1, 1), cB + hstep + kstep, voffB);
        PG8_WAIT_V(6); PG8_BAR;
    } else {
        PG8_STAGE(PG8_SB(0, 0), cB, voffB); PG8_STAGE(PG8_SA(0, 0), cA, voffA); PG8_STAGE(PG8_SB(0, 1), cB + hstep, voffB); PG8_STAGE(PG8_SA(0, 1), cA + hstep, voffA);
        if (wr == 1) PG8_BAR;
        PG8_WAIT_V(4); PG8_BAR;
        PG8_STAGE(PG8_SB(1, 0), cB + kstep, voffB); PG8_STAGE(PG8_SA(1, 0), cA + kstep, voffA); PG8_STAGE(PG8_SB(1, 1), cB + hstep + kstep, voffB);
        PG8_WAIT_V(6); PG8_BAR;
    }
    for (;;) {
        const bool has_next = S.next(ui + 1, nxt);
        const char* nA = has_next ? (const char*)g.A + (size_t)nxt.pm * tstep : cA; const char* nB = has_next ? (const char*)g.Bt + (size_t)nxt.pn * tstep : cB;
        for (int t = 0; t < nt; t += 2) {
            if constexpr (Epi::MIDK) { if (t == (nt >> 1)) E.midk(acc, wr, fr, tab); }
            const bool last = (t == nt - 2);
            const char* a1 = cA + (size_t)(t + 1) * kstep;
            const char* a2 = last ? nA : cA + (size_t)(t + 2) * kstep; const char* b2 = last ? nB : cB + (size_t)(t + 2) * kstep;
            const char* a3 = a2 + kstep; const char* b3 = b2 + kstep;
            if (last && has_next) S.a_ready(nxt);
            if constexpr (SP2) {
            PG8_LDB(B0, 0, 0); PG8_LDB(B1, 0, 1); PG8_SCHED; PG8_LDA(At, 0, 0); PG8_STAGE(PG8_SA(1, 1), a1 + hstep, voffA);
            PG8_WAIT_V(8); PG8_WAIT_L(0); PG8_BAR; PG8_MMA(0, 0, At, B0); PG8_MMA(0, 1, At, B1); PG8_BAR; PG8_SCHED;
            PG8_LDA(At, 0, 1); PG8_STAGE(PG8_SB(0, 0), b2, voffB); PG8_STAGE(PG8_SB(0, 1), b2 + hstep, voffB); PG8_STAGE(PG8_SA(0, 0), a2, voffA);
            PG8_WAIT_V(8); PG8_WAIT_L(0); PG8_BAR; PG8_MMA(1, 0, At, B0); PG8_MMA(1, 1, At, B1); PG8_BAR; PG8_SCHED;
            PG8_LDB(B0, 1, 0); PG8_LDB(B1, 1, 1); PG8_SCHED; PG8_LDA(At, 1, 0); PG8_STAGE(PG8_SA(0, 1), a2 + hstep, voffA);
            PG8_WAIT_V(8); PG8_WAIT_L(0); PG8_BAR; PG8_MMA(0, 0, At, B0); PG8_MMA(0, 1, At, B1); PG8_BAR; PG8_SCHED;
            PG8_LDA(At, 1, 1); PG8_STAGE(PG8_SB(1, 0), b3, voffB); PG8_STAGE(PG8_SB(1, 1), b3 + hstep, voffB); PG8_STAGE(PG8_SA(1, 0), a3, voffA);
            PG8_WAIT_V(8); PG8_WAIT_L(0); PG8_BAR; PG8_MMA(1, 0, At, B0); PG8_MMA(1, 1, At, B1); PG8_BAR; PG8_SCHED;
            } else {
            PG8_LDB(B0, 0, 0); PG8_SCHED; PG8_LDA(At, 0, 0); PG8_STAGE(PG8_SA(1, 1), a1 + hstep, voffA);
            PG8_WAIT_L(8); PG8_BAR; PG8_WAIT_L(0); PG8_MMA(0, 0, At, B0); PG8_BAR; PG8_SCHED;
            PG8_LDB(B1, 0, 1); PG8_STAGE(PG8_SB(0, 0), b2, voffB);
            PG8_BAR; PG8_WAIT_L(0); PG8_MMA(0, 1, At, B1); PG8_BAR;
            PG8_LDA(At, 0, 1); PG8_STAGE(PG8_SA(0, 0), a2, voffA);
            PG8_BAR; PG8_WAIT_L(0); PG8_MMA(1, 0, At, B0); PG8_BAR; PG8_SCHED;
            PG8_STAGE(PG8_SB(0, 1), b2 + hstep, voffB);
            PG8_WAIT_V(6); PG8_BAR; PG8_MMA(1, 1, At, B1); PG8_BAR;
            PG8_LDB(B0, 1, 0); PG8_SCHED; PG8_LDA(At, 1, 0); PG8_STAGE(PG8_SA(0, 1), a2 + hstep, voffA);
            PG8_WAIT_L(8); PG8_BAR; PG8_WAIT_L(0); PG8_MMA(0, 0, At, B0); PG8_BAR; PG8_SCHED;
            PG8_LDB(B1, 1, 1); PG8_STAGE(PG8_SB(1, 0), b3, voffB);
            PG8_BAR; PG8_WAIT_L(0); PG8_MMA(0, 1, At, B1); PG8_BAR;
            PG8_LDA(At, 1, 1); PG8_STAGE(PG8_SA(1, 0), a3, voffA);
            PG8_BAR; PG8_WAIT_L(0); PG8_MMA(1, 0, At, B0); PG8_BAR; PG8_SCHED;
            PG8_STAGE(PG8_SB(1, 1), b3 + hstep, voffB);
            PG8_WAIT_V(6); PG8_BAR; PG8_MMA(1, 1, At, B1); PG8_BAR;
            }
        }
        if constexpr (ALIGN_EPI) { if (wr == 0) PG8_BAR; }
        E(acc, cur, wr, wc, fr, fq, tab); S.done(cur);
        if (!has_next) break;
#pragma unroll
        for (int a = 0; a < 2; ++a)
#pragma unroll
            for (int b = 0; b < 2; ++b)
#pragma unroll
                for (int m = 0; m < 4; ++m)
#pragma unroll
                    for (int n = 0; n < 2; ++n) acc[a][b][m][n] = (f32x4){0.f, 0.f, 0.f, 0.f};
        cur = nxt; cA = nA; cB = nB; ++ui;
        if constexpr (ALIGN_EPI) { if (wr == 1) PG8_BAR; }
    }
    PG8_WAIT_V(0);
    if constexpr (!ALIGN_EPI) { if (wr == 0) PG8_BAR; }
    PG8_BAR;
#undef PG8_SA
#undef PG8_SB
#undef PG8_STAGE
#undef PG8_LDA
#undef PG8_LDB
#undef PG8_MMA
#undef PG8_WAIT_V
#undef PG8_WAIT_L
#undef PG8_BAR
#undef PG8_SCHED
}
}

#define PG8_SP2 true
#define PG8_ALIGN true

namespace attn {
typedef unsigned short bf16_t;
using bf16x8 = __attribute__((ext_vector_type(8))) short;
using s16x4  = __attribute__((ext_vector_type(4))) short;
using f32x16 = __attribute__((ext_vector_type(16))) float;
using u32x4  = __attribute__((ext_vector_type(4))) unsigned;
constexpr int NW = 8, QBLK = 32, KVBLK = 64;
constexpr int SHM_V = KVBLK * 128 * 2, SHM_K = KVBLK * 128 * 2, SHM_KP = KVBLK * 64 * 2;
constexpr int OFF_V = 0, OFF_K = 2 * SHM_V, OFF_WS = OFF_K + 2 * SHM_K, OFF_KP = OFF_WS + NW * 64 * 4, LDS_BYTES = OFF_KP + 2 * SHM_KP;
constexpr float THR = 8.f;
#define KSWZ(row, colB) ((row) * 256 + ((colB) ^ (((row) & 7) << 4)))
#define KPSWZ(row, colB) ((row) * 128 + ((colB) ^ (((row) & 7) << 4)))
#define SBAR() __builtin_amdgcn_sched_barrier(0)
__device__ __forceinline__ int crow(int r, int hi) { return (r & 3) + 8 * (r >> 2) + 4 * hi; }
__device__ __forceinline__ unsigned cvtpk(float lo, float hi) { unsigned r; asm volatile("v_cvt_pk_bf16_f32 %0, %1, %2" : "=v"(r) : "v"(lo), "v"(hi)); return r; }
__device__ __forceinline__ bf16x8 ld8(const bf16_t* p) { return *reinterpret_cast<const bf16x8*>(p); }

template <int DQK> struct Cst { static constexpr float SCALE = (DQK == 128) ? 0.088388347648318440f : 0.072168783648703220f; };

template <int DQK>
__device__ __forceinline__ void partialSM(f32x16& p0, f32x16& p1, float& m_reg, float& mn, float& alpha) {
  constexpr float SCALE = Cst<DQK>::SCALE, C = SCALE * 1.4426950408889634f;
  float pmax = p0[0];
#pragma unroll
  for (int r = 1; r < 16; ++r) pmax = fmaxf(pmax, p0[r]);
#pragma unroll
  for (int r = 0; r < 16; ++r) pmax = fmaxf(pmax, p1[r]);
  { auto rr = __builtin_amdgcn_permlane32_swap(__float_as_uint(pmax), __float_as_uint(pmax), false, false);
    pmax = fmaxf(__uint_as_float(rr[0]), __uint_as_float(rr[1])); }
  if (__builtin_expect(__all(pmax - m_reg <= THR / SCALE), 1)) { mn = m_reg; alpha = 1.f; }
  else { mn = fmaxf(m_reg, pmax); alpha = __builtin_amdgcn_exp2f((m_reg - mn) * C); m_reg = mn; }
  float mnC = -mn * C;
#pragma unroll
  for (int r = 0; r < 16; ++r) p0[r] = fmaf(p0[r], C, mnC);
#pragma unroll
  for (int r = 0; r < 16; ++r) p1[r] = fmaf(p1[r], C, mnC);
#pragma unroll
  for (int r = 0; r < 16; ++r) p0[r] = __builtin_amdgcn_exp2f(p0[r]);
}
__device__ __forceinline__ void finishSM(f32x16& p0, f32x16& p1, float alpha, float& l_reg, bf16x8& pa0, bf16x8& pa1, bf16x8& pa2, bf16x8& pa3) {
#pragma unroll
  for (int r = 0; r < 16; ++r) p1[r] = __builtin_amdgcn_exp2f(p1[r]);
  float ps = 0;
#pragma unroll
  for (int r = 0; r < 16; ++r) ps += p0[r];
#pragma unroll
  for (int r = 0; r < 16; ++r) ps += p1[r];
  { auto rr = __builtin_amdgcn_permlane32_swap(__float_as_uint(ps), __float_as_uint(ps), false, false);
    ps = __uint_as_float(rr[0]) + __uint_as_float(rr[1]); }
  l_reg = l_reg * alpha + ps;
#define PK4(P, BASE, OUT) do { unsigned a0 = cvtpk(P[BASE + 0], P[BASE + 1]), a1 = cvtpk(P[BASE + 2], P[BASE + 3]);   \
    unsigned b0 = cvtpk(P[BASE + 4], P[BASE + 5]), b1 = cvtpk(P[BASE + 6], P[BASE + 7]);                              \
    auto r0 = __builtin_amdgcn_permlane32_swap(a0, b0, false, false); auto r1 = __builtin_amdgcn_permlane32_swap(a1, b1, false, false); \
    u32x4 w = {r0[0], r1[0], r0[1], r1[1]}; OUT = *reinterpret_cast<bf16x8*>(&w); } while (0)
  PK4(p0, 0, pa0); PK4(p0, 8, pa1); PK4(p1, 0, pa2); PK4(p1, 8, pa3);
#undef PK4
}
template <int DQK>
__device__ __forceinline__ void qkt(f32x16& p0, f32x16& p1, const char* Ks, const char* Kps, const bf16x8* qr, int r32, int hi) {
  p0 = f32x16{}; p1 = f32x16{};
#pragma unroll
  for (int d0 = 0; d0 < 8; ++d0) { int cb = (d0 * 16 + hi * 8) * 2;
    bf16x8 b0 = *reinterpret_cast<const bf16x8*>(Ks + KSWZ(r32, cb));
    bf16x8 b1 = *reinterpret_cast<const bf16x8*>(Ks + KSWZ(32 + r32, cb));
    p0 = __builtin_amdgcn_mfma_f32_32x32x16_bf16(b0, qr[d0], p0, 0, 0, 0);
    p1 = __builtin_amdgcn_mfma_f32_32x32x16_bf16(b1, qr[d0], p1, 0, 0, 0); }
  if constexpr (DQK == 192) {
#pragma unroll
    for (int d0 = 0; d0 < 4; ++d0) { int cb = (d0 * 16 + hi * 8) * 2;
      bf16x8 b0 = *reinterpret_cast<const bf16x8*>(Kps + KPSWZ(r32, cb));
      bf16x8 b1 = *reinterpret_cast<const bf16x8*>(Kps + KPSWZ(32 + r32, cb));
      p0 = __builtin_amdgcn_mfma_f32_32x32x16_bf16(b0, qr[8 + d0], p0, 0, 0, 0);
      p1 = __builtin_amdgcn_mfma_f32_32x32x16_bf16(b1, qr[8 + d0], p1, 0, 0, 0); }
  }
}
__device__ __forceinline__ int v_st(int k, int c) { const int kk = (k & ~0xC) | ((k & 4) << 1) | ((k & 8) >> 1); return ((kk >> 3) * 4 + (c >> 5)) * 512 + ((kk & 7) * 32 + (c & 31)) * 2; }
__device__ __forceinline__ int v_rd_base(int lane) { return ((lane & 3) << 3) | (((lane >> 2) & 3) << 6) | (((lane >> 4) & 1) << 5) | (((lane >> 5) & 1) << 8); }
constexpr int v_rd_off(int d0, int ks, int half) { return d0 * 512 + ks * 4096 + half * 2048; }
template <int OFF> __device__ __forceinline__ s16x4 tr_read(int vb) {
  s16x4 r; asm volatile("ds_read_b64_tr_b16 %0, %1 offset:%2" : "=&v"(r) : "v"(vb), "i"(OFF) : "memory"); return r;
}
template <int D0> __device__ __forceinline__ void pv_one(f32x16& od, int vb, bf16x8 pa0, bf16x8 pa1, bf16x8 pa2, bf16x8 pa3) {
  const s16x4 l0 = tr_read<v_rd_off(D0, 0, 0)>(vb), h0 = tr_read<v_rd_off(D0, 0, 1)>(vb), l1 = tr_read<v_rd_off(D0, 1, 0)>(vb), h1 = tr_read<v_rd_off(D0, 1, 1)>(vb);
  const s16x4 l2 = tr_read<v_rd_off(D0, 2, 0)>(vb), h2 = tr_read<v_rd_off(D0, 2, 1)>(vb), l3 = tr_read<v_rd_off(D0, 3, 0)>(vb), h3 = tr_read<v_rd_off(D0, 3, 1)>(vb);
  asm volatile("s_waitcnt lgkmcnt(0)" ::: "memory"); SBAR();
#define PK(L, H) (bf16x8){L[0], L[1], L[2], L[3], H[0], H[1], H[2], H[3]}
  od = __builtin_amdgcn_mfma_f32_32x32x16_bf16(pa0, PK(l0, h0), od, 0, 0, 0);
  od = __builtin_amdgcn_mfma_f32_32x32x16_bf16(pa1, PK(l1, h1), od, 0, 0, 0);
  od = __builtin_amdgcn_mfma_f32_32x32x16_bf16(pa2, PK(l2, h2), od, 0, 0, 0);
  od = __builtin_amdgcn_mfma_f32_32x32x16_bf16(pa3, PK(l3, h3), od, 0, 0, 0);
#undef PK
}
__device__ __forceinline__ void pv_d0(f32x16* o, int vb, bf16x8 pa0, bf16x8 pa1, bf16x8 pa2, bf16x8 pa3) {
  pv_one<0>(o[0], vb, pa0, pa1, pa2, pa3); pv_one<1>(o[1], vb, pa0, pa1, pa2, pa3); pv_one<2>(o[2], vb, pa0, pa1, pa2, pa3); pv_one<3>(o[3], vb, pa0, pa1, pa2, pa3);
}

template <int DQK, int SDEPTH, int LDQ, int LDKN, int LDV>
__device__ __forceinline__ void attn_unit(const bf16_t* __restrict__ Qb, const bf16_t* __restrict__ Kn, const bf16_t* __restrict__ Kp, const bf16_t* __restrict__ Vh,
                                          bf16_t* __restrict__ Ob, float* __restrict__ ssq, int seq, char* lds, int wid_s) {
  constexpr int NQ = DQK / 16;
  unsigned z_s = 0u; asm volatile("" : "+v"(z_s));
  const int lane = __builtin_amdgcn_mbcnt_hi(~0u, __builtin_amdgcn_mbcnt_lo(~0u, z_s)), wid = wid_s, tid = wid_s * 64 + lane, r32 = lane & 31, hi = lane >> 5;
  char* V_lds = lds + OFF_V; char* K_lds = lds + OFF_K; char* Kp_lds = lds + OFF_KP;
  float* ws = (float*)(lds + OFF_WS) + wid * 64; float* li_l = ws; float* al_l = ws + 32;
  float m_reg = -1e30f, l_reg = 0; f32x16 o[4] = {}; bf16x8 qr[NQ];
  const bf16_t* Qw = Qb + (long)(wid * QBLK + r32) * LDQ + hi * 8;
#pragma unroll
  for (int d0 = 0; d0 < NQ; ++d0) qr[d0] = ld8(Qw + d0 * 16);
  const int sr = tid >> 4, sc = (tid & 15) * 8, vst0 = v_st(sr, sc), vst1 = v_st(32 + sr, sc);
  const int pr = tid >> 3, pc = (tid & 7) * 8;
  const int vb0 = (int)(uintptr_t)V_lds + v_rd_base(lane);
  struct { bf16x8 vs0, vs1, ks0, ks1, kp; } sr_[SDEPTH];
#define SLOAD(i, k0) do { sr_[i].vs0 = ld8(&Vh[(long)((k0) + sr) * LDV + sc]); sr_[i].vs1 = ld8(&Vh[(long)((k0) + 32 + sr) * LDV + sc]); \
    sr_[i].ks0 = ld8(&Kn[(long)((k0) + sr) * LDKN + sc]); sr_[i].ks1 = ld8(&Kn[(long)((k0) + 32 + sr) * LDKN + sc]); \
    if constexpr (DQK == 192) sr_[i].kp = ld8(&Kp[(long)((k0) + pr) * 64 + pc]); } while (0)
#define SWRITE(b, i) do { *(bf16x8*)(V_lds + (b) * SHM_V + vst0) = sr_[i].vs0;          \
    *(bf16x8*)(V_lds + (b) * SHM_V + vst1) = sr_[i].vs1; int kc = sc * 2;               \
    *(bf16x8*)(K_lds + (b) * SHM_K + KSWZ(sr, kc)) = sr_[i].ks0;                       \
    *(bf16x8*)(K_lds + (b) * SHM_K + KSWZ(32 + sr, kc)) = sr_[i].ks1;                  \
    if constexpr (DQK == 192) *(bf16x8*)(Kp_lds + (b) * SHM_KP + KPSWZ(pr, pc * 2)) = sr_[i].kp; } while (0)
#define SWAIT() do { if constexpr (SDEPTH == 2) { if constexpr (DQK == 192) asm volatile("s_waitcnt vmcnt(5)" ::: "memory"); else asm volatile("s_waitcnt vmcnt(4)" ::: "memory"); } \
    else asm volatile("s_waitcnt vmcnt(0)" ::: "memory"); } while (0)
#define RESC(a) do { if (__any((a) < 1.f)) { if (hi == 0) al_l[r32] = (a); asm volatile("s_waitcnt lgkmcnt(0)" ::: "memory"); \
    _Pragma("unroll") for (int d = 0; d < 4; ++d) _Pragma("unroll") for (int r = 0; r < 16; ++r) o[d][r] *= al_l[crow(r, hi)]; } } while (0)
  f32x16 pA0, pA1, pB0, pB1; float mnA, mnB, alA, alB; bf16x8 pa0, pa1, pa2, pa3; const int NT = seq / KVBLK;
  constexpr int SE = 0, SO = SDEPTH - 1;
  SLOAD(SE, 0); asm volatile("s_waitcnt vmcnt(0)" ::: "memory"); SWRITE(0, SE); __syncthreads();
  qkt<DQK>(pA0, pA1, K_lds, Kp_lds, qr, r32, hi); partialSM<DQK>(pA0, pA1, m_reg, mnA, alA);
  SLOAD(SO, KVBLK); if constexpr (SDEPTH == 2) { if (2 < NT) SLOAD(SE, 2 * KVBLK); }
  SWAIT(); SWRITE(1, SO); __syncthreads();
  for (int j = 1; j + 1 < NT; j += 2) {
    SBAR(); qkt<DQK>(pB0, pB1, K_lds + SHM_K, Kp_lds + SHM_KP, qr, r32, hi);
    finishSM(pA0, pA1, alA, l_reg, pa0, pa1, pa2, pa3); SBAR();
    SLOAD(SO, (j + SDEPTH) * KVBLK); SBAR();
    pv_d0(o, vb0, pa0, pa1, pa2, pa3); partialSM<DQK>(pB0, pB1, m_reg, mnB, alB);
    __syncthreads(); SWAIT(); SWRITE(0, SE);
    RESC(alB); __syncthreads();
    SBAR(); qkt<DQK>(pA0, pA1, K_lds, Kp_lds, qr, r32, hi);
    finishSM(pB0, pB1, alB, l_reg, pa0, pa1, pa2, pa3); SBAR();
    if (SDEPTH == 1 || j + 3 < NT) SLOAD(SE, (j + 1 + SDEPTH) * KVBLK); SBAR();
    pv_d0(o, vb0 + (int)SHM_V, pa0, pa1, pa2, pa3); partialSM<DQK>(pA0, pA1, m_reg, mnA, alA);
    __syncthreads(); SWAIT(); SWRITE(1, SO);
    RESC(alA); __syncthreads();
  }
  SBAR(); qkt<DQK>(pB0, pB1, K_lds + SHM_K, Kp_lds + SHM_KP, qr, r32, hi);
  finishSM(pA0, pA1, alA, l_reg, pa0, pa1, pa2, pa3); SBAR();
  pv_d0(o, vb0, pa0, pa1, pa2, pa3); partialSM<DQK>(pB0, pB1, m_reg, mnB, alB);
  __syncthreads(); RESC(alB);
  finishSM(pB0, pB1, alB, l_reg, pa0, pa1, pa2, pa3); SBAR();
  pv_d0(o, vb0 + (int)SHM_V, pa0, pa1, pa2, pa3);
  unsigned z_e = 0u; asm volatile("" : "+v"(z_e));
  const int lane_e_ = __builtin_amdgcn_mbcnt_hi(~0u, __builtin_amdgcn_mbcnt_lo(~0u, z_e));
  const int lane_e = lane_e_, r32e = lane_e & 31, hie = lane_e >> 5;
  float* li_e = (float*)(lds + OFF_WS) + wid_s * 64;
  if (hie == 0) li_e[r32e] = l_reg; asm volatile("s_waitcnt lgkmcnt(0)" ::: "memory");
  __syncthreads();
  bf16_t* stg = (bf16_t*)(lds + wid_s * 8192);
#pragma unroll
  for (int r = 0; r < 16; ++r) { const int orow = crow(r, hie); const float rl = __builtin_amdgcn_rcpf(li_e[orow]);
#pragma unroll
    for (int d0 = 0; d0 < 4; ++d0) { const unsigned w = cvtpk(o[d0][r] * rl, 0.f); stg[orow * 128 + d0 * 32 + r32e] = (bf16_t)(w & 0xffffu); } }
  asm volatile("s_waitcnt lgkmcnt(0)" ::: "memory");
  bf16_t* Ow = Ob + (long)(wid_s * QBLK) * 2048; float* sw = ssq + (long)(wid_s * QBLK) * 16;
#pragma unroll
  for (int i = 0; i < 8; ++i) { const int row = i * 4 + (lane_e >> 4), ch = lane_e & 15;
    const u32x4 v = *(const u32x4*)(stg + row * 128 + ch * 8);
    float s = 0.f;
#pragma unroll
    for (int e = 0; e < 4; ++e) { const float a = __uint_as_float(v[e] << 16), b = __uint_as_float(v[e] & 0xffff0000u); s += a * a + b * b; }
    s += __int_as_float(__builtin_amdgcn_ds_bpermute((lane_e ^ 1) << 2, __float_as_int(s))); s += __int_as_float(__builtin_amdgcn_ds_bpermute((lane_e ^ 2) << 2, __float_as_int(s)));
    s += __int_as_float(__builtin_amdgcn_ds_bpermute((lane_e ^ 4) << 2, __float_as_int(s))); s += __int_as_float(__builtin_amdgcn_ds_bpermute((lane_e ^ 8) << 2, __float_as_int(s)));
    *(u32x4*)(Ow + (long)row * 2048 + ch * 8) = v;
    if (ch == 0) sw[row * 16] = s; }
  __syncthreads();
#undef SLOAD
#undef SWRITE
#undef SWAIT
#undef RESC
}
#undef KSWZ
#undef KPSWZ
#undef SBAR
}

constexpr int NWAVES = 8;
constexpr int N_LAUNCHES = MK_N_LAUNCHES;
constexpr int PER_PHASE = 10;
constexpr int BATCH = 4, SEQ = 2048, DM = 2048, M = BATCH * SEQ;
constexpr int W_IN = 3648, W_INP = 3840, DFF = 8192, NMODW = 6 * DM;
constexpr float EPS = 1e-6f;

constexpr size_t MiB = 1u << 20;
constexpr size_t WS_CTL = 0, CTL_ZERO_BYTES = 64 * 1024;
constexpr size_t WS_MOD = 1 * MiB;
constexpr size_t WS_TAB = WS_MOD + 256 * 1024;
constexpr size_t WS_SSQC = 2 * MiB;
constexpr size_t WS_SSQO = WS_SSQC + 256 * 1024;
constexpr size_t WS_SSQP = WS_SSQO + 512 * 1024;
constexpr size_t WS_SSQY = WS_SSQP + 1024 * 1024;
constexpr size_t WS_WIN = 6 * MiB, WS_WKVB = 21 * MiB, WS_WOUT = 23 * MiB, WS_W1 = 31 * MiB, WS_W2 = 63 * MiB;
constexpr size_t WS_XN = 95 * MiB;
constexpr size_t WS_QA = 127 * MiB, WS_KA = 143 * MiB, WS_VA = 147 * MiB, WS_QB = 151 * MiB, WS_CKV = 175 * MiB, WS_KPE = 183 * MiB;
constexpr size_t WS_KVB = 184 * MiB, WS_OCAT = 216 * MiB, WS_OPROJ = 248 * MiB;
constexpr size_t WS_ACT = 127 * MiB;
constexpr size_t WS_Y = 280 * MiB, WS_END = 312 * MiB;
static_assert(WS_SSQY + 1024 * 1024 <= WS_WIN && WS_ACT + (size_t)M * DFF * 2 <= WS_Y, "d_ws map");
constexpr int CW_BAR = 1024;

constexpr int RING_OFF = 0, RING_BYTES = 131072;
constexpr int TAB_OFF = RING_BYTES;
constexpr int LDSCTL_OFF = TAB_OFF + 2048, MISC_OFF = LDSCTL_OFF + 320;
constexpr int LDS_BYTES = 147456;
static_assert(MISC_OFF + 128 <= LDS_BYTES && attn::LDS_BYTES <= RING_BYTES, "LDS map");

#define GAS __attribute__((address_space(1)))
#define LAS __attribute__((address_space(3)))
typedef unsigned short bf16;
typedef unsigned v4u __attribute__((ext_vector_type(4)));
typedef unsigned v2u __attribute__((ext_vector_type(2)));
typedef float f32x4 __attribute__((ext_vector_type(4)));
typedef GAS unsigned gu32;
#define RLX_AGENT __ATOMIC_RELAXED, __HIP_MEMORY_SCOPE_AGENT
#define LDS_WAIT() asm volatile("s_waitcnt lgkmcnt(0)" ::: "memory")
__device__ __forceinline__ unsigned f2bf(float f) { unsigned u = __builtin_bit_cast(unsigned, f); return (u + 0x7fffu + ((u >> 16) & 1u)) >> 16; }
__device__ __forceinline__ unsigned pk2(float lo, float hi) { return f2bf(lo) | (f2bf(hi) << 16); }
__device__ __forceinline__ float bflo(unsigned w) { return __uint_as_float(w << 16); }
__device__ __forceinline__ float bfhi(unsigned w) { return __uint_as_float(w & 0xffff0000u); }

#define XB_TMO      128
#define XB_XCNT(j)  (256  + 64 * (j))
#define XB_XSUB(j)  (1280 + 64 * (j))
#define XB_XGEN(j)  (2304 + 64 * (j))
#define XB_TOP      3328
#define XB_TOPGEN   3392
#define XCD_BAR_WORDS 3456
#define XB_SPIN_CAP (1u << 18)
__device__ __forceinline__ unsigned xb_ld(unsigned* p)              { return __hip_atomic_load(p, __ATOMIC_RELAXED, __HIP_MEMORY_SCOPE_AGENT); }
__device__ __forceinline__ unsigned xb_add(unsigned* p, unsigned v) { return __hip_atomic_fetch_add(p, v, __ATOMIC_RELAXED, __HIP_MEMORY_SCOPE_AGENT); }
__device__ __forceinline__ unsigned xb_xcc_id() { return (unsigned)__builtin_amdgcn_s_getreg((3 << 11) | 20) & 0xFu; }
#define XB_SPIN(cond, bar) do { unsigned _sp = 0; while (cond) { __builtin_amdgcn_s_sleep(1); \
    if ((++_sp & 255u) == 0u) { if (xb_ld(&(bar)[XB_TMO])) break; if (_sp > XB_SPIN_CAP) { atomicAdd(&(bar)[XB_TMO], 1u); break; } } } } while (0)
struct XcdBarrier { unsigned* bar; unsigned x; volatile LAS unsigned* st; };
__device__ __forceinline__ XcdBarrier xcd_barrier_post(unsigned* bar, volatile LAS unsigned* st) {
    XcdBarrier b; b.bar = bar; b.x = xb_xcc_id(); b.st = st;
    if (threadIdx.x == 0) (void)xb_add(&bar[XB_XCNT(b.x)], 1u);
    return b;
}
__device__ __forceinline__ void xcd_barrier_complete(unsigned* bar, unsigned x, unsigned& nloc, unsigned& nx) {
    const unsigned G = gridDim.x * gridDim.y * gridDim.z;
    unsigned sum, cnt, mine, sp = 0u;
    for (;;) {
        sum = 0u; cnt = 0u; mine = 0u;
#pragma unroll
        for (unsigned j = 0; j < 16; ++j) { const unsigned c = xb_ld(&bar[XB_XCNT(j)]); sum += c; cnt += (c > 0u) ? 1u : 0u; mine = (j == x) ? c : mine; }
        if (sum == G) break;
        __builtin_amdgcn_s_sleep(1);
        if ((++sp & 255u) == 0u) { if (xb_ld(&bar[XB_TMO])) break; if (sp > XB_SPIN_CAP) { atomicAdd(&bar[XB_TMO], 1u); break; } }
    }
    nloc = mine > 0u ? mine : 1u; nx = cnt > 0u ? cnt : 1u;
}
__device__ __forceinline__ void xcd_barrier(const XcdBarrier& b) {
    asm volatile("s_waitcnt vmcnt(0)" ::: "memory");
    __syncthreads();
    if (threadIdx.x == 0) {
        unsigned* bar = b.bar;
        __builtin_amdgcn_s_waitcnt(0);
        unsigned nloc = b.st[0], nx = b.st[1];
        if (nloc == 0u) { xcd_barrier_complete(bar, b.x, nloc, nx); b.st[0] = nloc; b.st[1] = nx; }
        const unsigned old = xb_add(&bar[XB_XSUB(b.x)], 1u);
        const unsigned gen = old / nloc;
        if (old + 1u == (gen + 1u) * nloc) {
            __builtin_amdgcn_fence(__ATOMIC_RELEASE, "agent");
            asm volatile("s_waitcnt vmcnt(0)" ::: "memory");
            const unsigned og = xb_add(&bar[XB_TOP], 1u);
            const unsigned tg = og / nx;
            if (og + 1u == (tg + 1u) * nx) xb_add(&bar[XB_TOPGEN], 1u);
            else XB_SPIN(xb_ld(&bar[XB_TOPGEN]) == tg, bar);
            __builtin_amdgcn_fence(__ATOMIC_ACQUIRE, "agent");
            xb_add(&bar[XB_XGEN(b.x)], 1u);
            asm volatile("s_waitcnt vmcnt(0)" ::: "memory");
        } else {
            XB_SPIN(xb_ld(&bar[XB_XGEN(b.x)]) == gen, bar);
            __builtin_amdgcn_fence(__ATOMIC_ACQUIRE, "agent");
            asm volatile("s_waitcnt vmcnt(0)" ::: "memory");
        }
    }
    __syncthreads();
}

struct Frame {
    LAS unsigned char* lds;
    volatile LAS unsigned* MISC;
    gu32* ctl;
    int tid, lane, wave;
    int vcu, G;
    const float *x, *c, *w_ada, *b_ada, *g_pre_attn, *w_in, *g_q_a, *g_k_a, *g_ckv, *w_kv_b, *g_out_a, *g_out_b, *w_out, *g_post_attn, *g_pre_mlp, *w_mlp_in, *w_mlp_out, *g_post_mlp;
    float* out;
    float *mod, *tab, *ssqc, *ssqo, *ssqp, *ssqy;
    bf16 *Win_t, *Wkvb_t, *Wout_t, *W1_t, *W2_t;
    bf16 *XN, *QA, *KA, *VA, *QB, *CKV, *KPE, *KVB, *OCAT, *OPROJ, *ACT, *Y;
};

__device__ __forceinline__ int fresh_lane() { unsigned z = 0u; asm volatile("" : "+v"(z)); return (int)__builtin_amdgcn_mbcnt_hi(~0u, __builtin_amdgcn_mbcnt_lo(~0u, z)); }
#define PHASE_BEGIN() do { F.lane = fresh_lane(); F.tid = F.wave * 64 + F.lane; } while (0)
__device__ __forceinline__ float wave_sum(float v) {
#pragma unroll
    for (int o = 1; o < 64; o <<= 1) v += __shfl_xor(v, o);
    return v;
}

__device__ __forceinline__ void p0_gemv_item(Frame& F, int j) {
    LAS float* sact = (LAS float*)(F.lds);
    LAS float* red = (LAS float*)(F.lds + 32768);
    for (int i = F.tid; i < 4 * DM; i += NWAVES * 64) { const float v = F.c[i]; sact[i] = v / (1.0f + expf(-v)); }
    __syncthreads();
    const int n0 = 64 * j, rsub = F.lane >> 4, c4 = (F.lane & 15) * 4;
    const float* wp = F.w_ada + (size_t)(256 * F.wave + rsub) * NMODW + n0 + c4;
    f32x4 a0 = {0.f, 0.f, 0.f, 0.f}, a1 = a0, a2 = a0, a3 = a0;
#pragma unroll 8
    for (int i = 0; i < 64; ++i) {
        const f32x4 wv = *(const f32x4*)(wp + (size_t)i * 4 * NMODW);
        const int k = 256 * F.wave + 4 * i + rsub;
        a0 += sact[k] * wv; a1 += sact[DM + k] * wv; a2 += sact[2 * DM + k] * wv; a3 += sact[3 * DM + k] * wv;
    }
#pragma unroll
    for (int e = 0; e < 4; ++e) {
        a0[e] += __shfl_xor(a0[e], 16); a0[e] += __shfl_xor(a0[e], 32);
        a1[e] += __shfl_xor(a1[e], 16); a1[e] += __shfl_xor(a1[e], 32);
        a2[e] += __shfl_xor(a2[e], 16); a2[e] += __shfl_xor(a2[e], 32);
        a3[e] += __shfl_xor(a3[e], 16); a3[e] += __shfl_xor(a3[e], 32);
    }
    if (rsub == 0) {
#pragma unroll
        for (int e = 0; e < 4; ++e) { red[(F.wave * 4 + 0) * 64 + c4 + e] = a0[e]; red[(F.wave * 4 + 1) * 64 + c4 + e] = a1[e]; red[(F.wave * 4 + 2) * 64 + c4 + e] = a2[e]; red[(F.wave * 4 + 3) * 64 + c4 + e] = a3[e]; }
    }
    __syncthreads();
    if (F.tid < 256) { const int b = F.tid >> 6, n = F.tid & 63; float s = 0.f;
#pragma unroll
        for (int w = 0; w < 8; ++w) s += red[(w * 4 + b) * 64 + n];
        F.mod[b * NMODW + n0 + n] = s + F.b_ada[n0 + n]; }
    __syncthreads();
}
__device__ __forceinline__ void p0_transpose_item(const float* W, int K, int N, bf16* WT, const float* ks, LAS float* scr, int item, int lane) {
    const int nblk = N / 32, kb = item / nblk, nb = item % nblk, k0 = 64 * kb, n0 = 32 * nb;
#pragma unroll 8
    for (int i = 0; i < 32; ++i) { const int kk = 2 * i + (lane >> 5); float v = W[(size_t)(k0 + kk) * N + n0 + (lane & 31)]; if (ks) v *= ks[k0 + kk]; scr[kk * 33 + (lane & 31)] = v; }
    LDS_WAIT(); asm volatile("" ::: "memory");
    const int c = lane & 7;
#pragma unroll
    for (int j = 0; j < 4; ++j) { const int n = (lane >> 3) + 8 * j; const LAS float* s = scr + (8 * c) * 33 + n;
        v4u o; o.x = pk2(s[0 * 33], s[1 * 33]); o.y = pk2(s[2 * 33], s[3 * 33]); o.z = pk2(s[4 * 33], s[5 * 33]); o.w = pk2(s[6 * 33], s[7 * 33]);
        *(GAS v4u*)(WT + (size_t)(n0 + n) * K + k0 + 8 * c) = o; }
    LDS_WAIT(); asm volatile("" ::: "memory");
}
__device__ __forceinline__ void p0_prologue(Frame& F) {
    const int bid = blockIdx.x;
    const bool gemvwg = bid < 192;
    if (gemvwg) p0_gemv_item(F, bid);
    if (bid == (int)gridDim.x - 1) {
        for (int idx = F.tid; idx < 64 * 32; idx += NWAVES * 64) { const int p = idx >> 5, i = idx & 31; const float inv = powf(10000.0f, -(float)(2 * i) / 64.0f); const float ang = (float)p * inv;
            F.tab[idx] = cosf(ang); F.tab[2048 + idx] = sinf(ang); }
        for (int idx = F.tid; idx < 64 * 16; idx += NWAVES * 64) { const int p = idx >> 4, i = idx & 15; const float inv = powf(10000.0f, -(float)(2 * i) / 32.0f); const float ang = (float)p * inv;
            F.tab[4096 + idx] = cosf(ang); F.tab[5120 + idx] = sinf(ang); }
    }
    LAS float* scr = (LAS float*)(F.lds + RING_OFF + F.wave * 16384);
    constexpr int I_IN = (DM / 64) * (W_IN / 32), I_KVB = (512 / 64) * (2048 / 32), I_OUT = (DM / 64) * (DM / 32), I_1 = (DM / 64) * (DFF / 32), I_2 = (DFF / 64) * (DM / 32);
    constexpr int NITEMS = I_IN + I_KVB + I_OUT + I_1 + I_2;
    int it, stride, limit;
    if ((int)gridDim.x == 256) {
        if (gemvwg) { it = bid * 8 + F.wave; stride = 1536; limit = 13824; }
        else { it = 13824 + (bid - 192) * 8 + F.wave; stride = 512; limit = NITEMS; }
    } else { it = bid * 8 + F.wave; stride = (int)gridDim.x * 8; limit = NITEMS; }
    for (; it < limit; it += stride) {
        int r = it;
        if (r < I_IN) { p0_transpose_item(F.w_in, DM, W_IN, F.Win_t, nullptr, scr, r, F.lane); continue; } r -= I_IN;
        if (r < I_KVB) { p0_transpose_item(F.w_kv_b, 512, 2048, F.Wkvb_t, F.g_ckv, scr, r, F.lane); continue; } r -= I_KVB;
        if (r < I_OUT) { const int kb = r / (DM / 32); const float* ks = (kb < 16) ? F.g_out_a : (F.g_out_b - 1024);
            p0_transpose_item(F.w_out, DM, DM, F.Wout_t, ks, scr, r, F.lane); continue; } r -= I_OUT;
        if (r < I_1) { p0_transpose_item(F.w_mlp_in, DM, DFF, F.W1_t, nullptr, scr, r, F.lane); continue; } r -= I_1;
        p0_transpose_item(F.w_mlp_out, DFF, DM, F.W2_t, nullptr, scr, r, F.lane);
    }
}
__device__ __forceinline__ void p1_rows(Frame& F) {
    const int gw = F.vcu * NWAVES + F.wave, NGW = F.G * NWAVES;
    for (int m = gw; m < M; m += NGW) {
        const int b = m >> 11; const float* sh = F.mod + b * NMODW; const float* scp = sh + DM;
        const f32x4* xr = (const f32x4*)(F.x + (size_t)m * DM) + F.lane;
        f32x4 v[8]; float s = 0.f;
#pragma unroll
        for (int j = 0; j < 8; ++j) { v[j] = xr[64 * j]; s += (v[j][0] * v[j][0] + v[j][1] * v[j][1]) + (v[j][2] * v[j][2] + v[j][3] * v[j][3]); }
        const float inv = 1.0f / sqrtf(wave_sum(s) * (1.0f / DM) + EPS);
        v2u* o8 = (v2u*)(F.XN + (size_t)m * DM) + F.lane;
#pragma unroll
        for (int j = 0; j < 8; ++j) { const int k = 4 * F.lane + 256 * j;
            const f32x4 g = *(const f32x4*)(F.g_pre_attn + k), sc = *(const f32x4*)(scp + k), sf = *(const f32x4*)(sh + k);
            const f32x4 h = v[j] * inv * g * (1.0f + sc) + sf;
            v2u w; w.x = pk2(h[0], h[1]); w.y = pk2(h[2], h[3]); o8[64 * j] = w; }
    }
}
__device__ __forceinline__ void p6_rows(Frame& F) {
    const int gw = F.vcu * NWAVES + F.wave, NGW = F.G * NWAVES;
    for (int m = gw; m < M; m += NGW) {
        const int b = m >> 11; const float* md = F.mod + b * NMODW; const float* gt = md + 2 * DM; const float* shm = md + 3 * DM; const float* scm = md + 4 * DM;
        const float ps = (F.lane < 32) ? F.ssqp[(size_t)m * 32 + F.lane] : 0.f;
        const float invo = 1.0f / sqrtf(wave_sum(ps) * (1.0f / DM) + EPS);
        const f32x4* xr = (const f32x4*)(F.x + (size_t)m * DM) + F.lane;
        const v2u* pr = (const v2u*)(F.OPROJ + (size_t)m * DM) + F.lane;
        f32x4* orow = (f32x4*)(F.out + (size_t)m * DM) + F.lane;
        f32x4 v[8]; float s = 0.f;
#pragma unroll
        for (int j = 0; j < 8; ++j) { const int k = 4 * F.lane + 256 * j;
            const v2u w = pr[64 * j]; const f32x4 op = {bflo(w.x), bfhi(w.x), bflo(w.y), bfhi(w.y)};
            const f32x4 g = *(const f32x4*)(F.g_post_attn + k), gg = *(const f32x4*)(gt + k);
            v[j] = xr[64 * j] + gg * (op * invo * g);
            orow[64 * j] = v[j];
            s += (v[j][0] * v[j][0] + v[j][1] * v[j][1]) + (v[j][2] * v[j][2] + v[j][3] * v[j][3]); }
        const float inv = 1.0f / sqrtf(wave_sum(s) * (1.0f / DM) + EPS);
        v2u* o8 = (v2u*)(F.XN + (size_t)m * DM) + F.lane;
#pragma unroll
        for (int j = 0; j < 8; ++j) { const int k = 4 * F.lane + 256 * j;
            const f32x4 g = *(const f32x4*)(F.g_pre_mlp + k), sc = *(const f32x4*)(scm + k), sf = *(const f32x4*)(shm + k);
            const f32x4 h = v[j] * inv * g * (1.0f + sc) + sf;
            v2u w; w.x = pk2(h[0], h[1]); w.y = pk2(h[2], h[3]); o8[64 * j] = w; }
    }
}
__device__ __forceinline__ void p9_rows(Frame& F) {
    const int gw = F.vcu * NWAVES + F.wave, NGW = F.G * NWAVES;
    for (int m = gw; m < M; m += NGW) {
        const int b = m >> 11; const float* gt = F.mod + b * NMODW + 5 * DM;
        const float ps = (F.lane < 32) ? F.ssqy[(size_t)m * 32 + F.lane] : 0.f;
        const float invy = 1.0f / sqrtf(wave_sum(ps) * (1.0f / DM) + EPS);
        const v2u* yr = (const v2u*)(F.Y + (size_t)m * DM) + F.lane;
        f32x4* orow = (f32x4*)(F.out + (size_t)m * DM) + F.lane;
#pragma unroll
        for (int j = 0; j < 8; ++j) { const int k = 4 * F.lane + 256 * j;
            const v2u w = yr[64 * j]; const f32x4 yv = {bflo(w.x), bfhi(w.x), bflo(w.y), bfhi(w.y)};
            const f32x4 g = *(const f32x4*)(F.g_post_mlp + k), gg = *(const f32x4*)(gt + k);
            orow[64 * j] = orow[64 * j] + gg * (yv * invy * g); }
    }
}
__device__ __forceinline__ void rope8(float (&x)[8], int j, int prow, int pcol, const float* tab) {
    const int pos = (j & 4) ? pcol : prow, fi0 = 8 * (j & 1); const float sgn = (j & 2) ? 1.f : -1.f;
    const float* ct = tab + 4096 + pos * 16 + fi0; const float* st = tab + 5120 + pos * 16 + fi0;
#pragma unroll
    for (int e = 0; e < 8; ++e) { const float part = __shfl_xor(x[e], 2); x[e] = x[e] * ct[e] + sgn * part * st[e]; }
}
__device__ __forceinline__ void normrope16(float (&x)[16], int j, int prow, int pcol, const float* g, const float* tab) {
    float ss = 0.f;
#pragma unroll
    for (int e = 0; e < 16; ++e) ss += x[e] * x[e];
    ss += __shfl_xor(ss, 1); ss += __shfl_xor(ss, 2); ss += __shfl_xor(ss, 4);
    const float inv = 1.0f / sqrtf(ss * (1.0f / 128.0f) + EPS);
    const int pos = (j & 4) ? pcol : prow, fi0 = 16 * (j & 1); const float sgn = (j & 2) ? 1.f : -1.f;
    const float* ct = tab + pos * 32 + fi0; const float* st = tab + 2048 + pos * 32 + fi0;
#pragma unroll
    for (int e = 0; e < 16; ++e) x[e] = x[e] * inv * g[16 * j + e];
#pragma unroll
    for (int e = 0; e < 16; ++e) { const float part = __shfl_xor(x[e], 2); x[e] = x[e] * ct[e] + sgn * part * st[e]; }
}
__device__ __forceinline__ void p3_fixup_rows(Frame& F) {
    const int gw = F.vcu * NWAVES + F.wave, NGW = F.G * NWAVES; const int l = F.lane, j = l & 7;
    for (int m = gw; m < M; m += NGW) {
        const int t = m & (SEQ - 1), prow = t >> 6, pcol = t & 63;
        {
            v4u* p = (v4u*)(F.QA + (size_t)m * 1024 + 16 * l); const v4u w0 = p[0], w1 = p[1]; float x[16];
#pragma unroll
            for (int e = 0; e < 4; ++e) { x[2 * e] = bflo(w0[e]); x[2 * e + 1] = bfhi(w0[e]); x[8 + 2 * e] = bflo(w1[e]); x[8 + 2 * e + 1] = bfhi(w1[e]); }
            normrope16(x, j, prow, pcol, F.g_q_a, F.tab);
            v4u o0, o1;
#pragma unroll
            for (int e = 0; e < 4; ++e) { o0[e] = pk2(x[2 * e], x[2 * e + 1]); o1[e] = pk2(x[8 + 2 * e], x[8 + 2 * e + 1]); }
            p[0] = o0; p[1] = o1;
        }
        {
            v4u* p = (v4u*)(F.KA + (size_t)m * 256 + 16 * (l & 15)); const v4u w0 = p[0], w1 = p[1]; float x[16];
#pragma unroll
            for (int e = 0; e < 4; ++e) { x[2 * e] = bflo(w0[e]); x[2 * e + 1] = bfhi(w0[e]); x[8 + 2 * e] = bflo(w1[e]); x[8 + 2 * e + 1] = bfhi(w1[e]); }
            normrope16(x, j, prow, pcol, F.g_k_a, F.tab);
            v4u o0, o1;
#pragma unroll
            for (int e = 0; e < 4; ++e) { o0[e] = pk2(x[2 * e], x[2 * e + 1]); o1[e] = pk2(x[8 + 2 * e], x[8 + 2 * e + 1]); }
            if (l < 16) { p[0] = o0; p[1] = o1; }
        }
        {
            v4u* p = (v4u*)(F.QB + (size_t)m * 1536 + 192 * (l >> 3) + 128 + 8 * j); const v4u w = p[0]; float x[8];
#pragma unroll
            for (int e = 0; e < 4; ++e) { x[2 * e] = bflo(w[e]); x[2 * e + 1] = bfhi(w[e]); }
            rope8(x, j, prow, pcol, F.tab);
            v4u o;
#pragma unroll
            for (int e = 0; e < 4; ++e) o[e] = pk2(x[2 * e], x[2 * e + 1]);
            p[0] = o;
        }
        {
            v4u* p = (v4u*)(F.KPE + (size_t)m * 64 + 8 * j); const v4u w = p[0]; float x[8];
#pragma unroll
            for (int e = 0; e < 4; ++e) { x[2 * e] = bflo(w[e]); x[2 * e + 1] = bfhi(w[e]); }
            rope8(x, j, prow, pcol, F.tab);
            v4u o;
#pragma unroll
            for (int e = 0; e < 4; ++e) o[e] = pk2(x[2 * e], x[2 * e + 1]);
            if (l < 8) p[0] = o;
        }
    }
}

struct Args { const float* in[18]; float* out; unsigned char* ws; int ph_lo, ph_hi, li, pad; };
__global__ void __launch_bounds__(NWAVES * 64, 2) mk_fwd(Args args) {
    extern __shared__ __attribute__((aligned(16))) unsigned char lds[];
    Frame F;
    F.lds = (LAS unsigned char*)lds;
    F.MISC = (volatile LAS unsigned*)(F.lds + MISC_OFF);
    F.tid = threadIdx.x; F.lane = F.tid & 63; F.wave = __builtin_amdgcn_readfirstlane(F.tid >> 6);
    F.G = gridDim.x; { const int bx = blockIdx.x; F.vcu = (F.G % 8 == 0) ? (bx % 8) * (F.G / 8) + bx / 8 : bx; }
    unsigned char* ws = args.ws;
    F.ctl = (gu32*)(ws + WS_CTL);
    F.x = args.in[0]; F.c = args.in[1]; F.w_ada = args.in[2]; F.b_ada = args.in[3]; F.g_pre_attn = args.in[4]; F.w_in = args.in[5]; F.g_q_a = args.in[6]; F.g_k_a = args.in[7];
    F.g_ckv = args.in[8]; F.w_kv_b = args.in[9]; F.g_out_a = args.in[10]; F.g_out_b = args.in[11]; F.w_out = args.in[12]; F.g_post_attn = args.in[13]; F.g_pre_mlp = args.in[14];
    F.w_mlp_in = args.in[15]; F.w_mlp_out = args.in[16]; F.g_post_mlp = args.in[17]; F.out = args.out;
    F.mod = (float*)(ws + WS_MOD); F.tab = (float*)(ws + WS_TAB); F.ssqc = (float*)(ws + WS_SSQC); F.ssqo = (float*)(ws + WS_SSQO); F.ssqp = (float*)(ws + WS_SSQP); F.ssqy = (float*)(ws + WS_SSQY);
    F.Win_t = (bf16*)(ws + WS_WIN); F.Wkvb_t = (bf16*)(ws + WS_WKVB); F.Wout_t = (bf16*)(ws + WS_WOUT); F.W1_t = (bf16*)(ws + WS_W1); F.W2_t = (bf16*)(ws + WS_W2);
    F.XN = (bf16*)(ws + WS_XN); F.QA = (bf16*)(ws + WS_QA); F.KA = (bf16*)(ws + WS_KA); F.VA = (bf16*)(ws + WS_VA); F.QB = (bf16*)(ws + WS_QB); F.CKV = (bf16*)(ws + WS_CKV); F.KPE = (bf16*)(ws + WS_KPE);
    F.KVB = (bf16*)(ws + WS_KVB); F.OCAT = (bf16*)(ws + WS_OCAT); F.OPROJ = (bf16*)(ws + WS_OPROJ); F.ACT = (bf16*)(ws + WS_ACT); F.Y = (bf16*)(ws + WS_Y);
    for (int u = F.tid; u < (LDS_BYTES - LDSCTL_OFF) / 4; u += NWAVES * 64) ((LAS unsigned*)(F.lds + LDSCTL_OFF))[u] = 0u;
    __syncthreads();
    XcdBarrier bar; bar.bar = (unsigned*)(F.ctl + CW_BAR); bar.x = 0; bar.st = nullptr;
    if (N_LAUNCHES == 1 && !MK_CG_ALL) bar = xcd_barrier_post((unsigned*)(F.ctl + CW_BAR), F.MISC + 8);
    const int lo = args.ph_lo, hi = args.ph_hi;
#ifndef PHMASK
#define PHMASK 0x3ff
#endif
#define IN(k) (((PHMASK >> (k)) & 1) && lo <= (k) && (k) < hi)
#define BOTH(k) (IN(k) && IN((k) + 1))
#define SEAM(k) do { if (BOTH(k)) { if (MK_CG_ALL || (k) == 0) cg::this_grid().sync(); else xcd_barrier(bar); } } while (0)

    if (IN(0)) { PHASE_BEGIN(); p0_prologue(F); SEAM(0); }
    if (IN(1)) { PHASE_BEGIN(); p1_rows(F); SEAM(1); }
    if (IN(2)) { PHASE_BEGIN();
        pg8::Gemm g{F.XN, F.Win_t, M, W_INP, DM}; pg8::StaticOrder S; S.init(M, W_INP, F.G, (int)blockIdx.x);
        pg8::EpiProj E{F.QA, F.KA, F.VA, F.QB, F.CKV, F.KPE, F.ssqc};
        pg8::gemm_phase<pg8::EpiProj, pg8::StaticOrder, PG8_ALIGN, PG8_SP2>(F.lds + RING_OFF, F.lds + TAB_OFF, g, S, E, F.tid, F.wave);
        SEAM(2);
    }
    if (IN(3)) { PHASE_BEGIN();
        pg8::Gemm g{F.CKV, F.Wkvb_t, M, 2048, 512}; pg8::StaticOrder S; S.init(M, 2048, F.G, (int)blockIdx.x);
        pg8::EpiKvb E{F.KVB, F.ssqc};
        pg8::gemm_phase<pg8::EpiKvb, pg8::StaticOrder, PG8_ALIGN, PG8_SP2>(F.lds + RING_OFF, F.lds + TAB_OFF, g, S, E, F.tid, F.wave);
        p3_fixup_rows(F);
        SEAM(3);
    }
    if (IN(4)) { PHASE_BEGIN();
        for (int u = F.vcu; u < 256; u += F.G) {
#ifndef ATT_SEL
#define ATT_SEL 3
#endif
            if (ATT_SEL & 1) {   const int pair = u >> 5, b = pair >> 1, kvh = pair & 1, r = u & 31, h = kvh * 4 + (r >> 3), qb = r & 7; const size_t row0 = (size_t)b * SEQ + qb * 256;
                attn::attn_unit<128, 2, 1024, 256, 256>(F.QA + row0 * 1024 + h * 128, F.KA + (size_t)b * SEQ * 256 + kvh * 128, nullptr, F.VA + (size_t)b * SEQ * 256 + kvh * 128,
                                                       F.OCAT + row0 * 2048 + h * 128, F.ssqo + row0 * 16 + h, SEQ, (char*)lds + RING_OFF, F.wave); }
            if (ATT_SEL & 2) {   const int pair = u >> 3, b = pair >> 3, h = pair & 7, qb = u & 7; const size_t row0 = (size_t)b * SEQ + qb * 256;
                attn::attn_unit<192, 1, 1536, 2048, 2048>(F.QB + row0 * 1536 + h * 192, F.KVB + (size_t)b * SEQ * 2048 + h * 256, F.KPE + (size_t)b * SEQ * 64, F.KVB + (size_t)b * SEQ * 2048 + h * 256 + 128,
                                                         F.OCAT + row0 * 2048 + 1024 + h * 128, F.ssqo + row0 * 16 + 8 + h, SEQ, (char*)lds + RING_OFF, F.wave); }
        }
        SEAM(4);
    }
    if (IN(5)) { PHASE_BEGIN();
        pg8::StaticOrder S; S.init(M, DM, F.G, (int)blockIdx.x);
        pg8::Unit u0; if (S.next(0, u0)) {
            if (F.tid < 256) { const float* sp = F.ssqo + (size_t)(u0.pm * 256 + F.tid) * 16;
                const f32x4 a0 = *(const f32x4*)sp, a1 = *(const f32x4*)(sp + 4), b0 = *(const f32x4*)(sp + 8), b1 = *(const f32x4*)(sp + 12);
                const float sa = ((a0[0] + a0[1]) + (a0[2] + a0[3])) + ((a1[0] + a1[1]) + (a1[2] + a1[3])), sb = ((b0[0] + b0[1]) + (b0[2] + b0[3])) + ((b1[0] + b1[1]) + (b1[2] + b1[3]));
                const float ra = 1.0f / sqrtf(sa * (1.0f / 1024.0f) + EPS), rb = 1.0f / sqrtf(sb * (1.0f / 1024.0f) + EPS);
                LAS float* T = (LAS float*)(F.lds + TAB_OFF); T[F.tid] = ra / rb; T[256 + F.tid] = rb; }
        }
        __syncthreads();
        pg8::Gemm g{F.OCAT, F.Wout_t, M, DM, DM};
        pg8::EpiGen<0, true, true> E{F.OPROJ, DM, F.ssqp, 32};
        pg8::gemm_phase<pg8::EpiGen<0, true, true>, pg8::StaticOrder, PG8_ALIGN, PG8_SP2>(F.lds + RING_OFF, F.lds + TAB_OFF, g, S, E, F.tid, F.wave);
        SEAM(5);
    }
    if (IN(6)) { PHASE_BEGIN(); p6_rows(F); SEAM(6); }
    if (IN(7)) { PHASE_BEGIN();
        pg8::Gemm g{F.XN, F.W1_t, M, DFF, DM}; pg8::StaticOrder S; S.init(M, DFF, F.G, (int)blockIdx.x);
        pg8::EpiGen<1, false, false> E{F.ACT, DFF, nullptr, 0};
        pg8::gemm_phase<pg8::EpiGen<1, false, false>, pg8::StaticOrder, PG8_ALIGN, PG8_SP2>(F.lds + RING_OFF, F.lds + TAB_OFF, g, S, E, F.tid, F.wave);
        SEAM(7);
    }
    if (IN(8)) { PHASE_BEGIN();
        pg8::Gemm g{F.ACT, F.W2_t, M, DM, DFF}; pg8::StaticOrder S; S.init(M, DM, F.G, (int)blockIdx.x);
        pg8::EpiGen<0, false, true> E{F.Y, DM, F.ssqy, 32};
        pg8::gemm_phase<pg8::EpiGen<0, false, true>, pg8::StaticOrder, PG8_ALIGN, PG8_SP2>(F.lds + RING_OFF, F.lds + TAB_OFF, g, S, E, F.tid, F.wave);
        SEAM(8);
    }
    if (IN(9)) { PHASE_BEGIN(); p9_rows(F); }
#undef IN
#undef BOTH
#undef SEAM
}

extern "C" void kernel_launch(void* const* d_in, const int* in_sizes, int n_in, void* d_out, int out_size, void* d_ws, size_t ws_size, hipStream_t stream) {
    static int grid = 0;
    if (grid == 0) {
        if (n_in != 18 || in_sizes[0] != M * DM || out_size != M * DM || ws_size < WS_END) { fprintf(stderr, "kernel_launch: shape/workspace mismatch (n_in %d, in0 %d, out %d, ws %zu)\n", n_in, n_in > 0 ? in_sizes[0] : -1, out_size, ws_size); grid = -1; return; }
        int dev = 0, cus = 0, per_cu = 0;
        if (hipGetDevice(&dev) != hipSuccess || hipDeviceGetAttribute(&cus, hipDeviceAttributeMultiprocessorCount, dev) != hipSuccess) { grid = -1; return; }
        if (hipFuncSetAttribute((const void*)mk_fwd, hipFuncAttributeMaxDynamicSharedMemorySize, LDS_BYTES) != hipSuccess) { fprintf(stderr, "kernel_launch: hipFuncSetAttribute failed\n"); grid = -1; return; }
        if (hipOccupancyMaxActiveBlocksPerMultiprocessor(&per_cu, (const void*)mk_fwd, NWAVES * 64, LDS_BYTES) != hipSuccess || per_cu < 1) { fprintf(stderr, "kernel_launch: occupancy query says %d blocks/CU\n", per_cu); per_cu = 1; }
        (void)hipGetLastError();
        grid = cus;
        if (grid != 256) fprintf(stderr, "kernel_launch: %d CUs (tuned for 256)\n", grid);
    }
    if (grid < 0) return;
    (void)hipMemsetAsync((char*)d_ws + WS_CTL, 0, CTL_ZERO_BYTES, stream);
    Args a{};
    for (int i = 0; i < 18; ++i) a.in[i] = (const float*)d_in[i];
    a.out = (float*)d_out; a.ws = (unsigned char*)d_ws;
    if (N_LAUNCHES == 1) {
        a.ph_lo = 0; a.ph_hi = PER_PHASE; a.li = 0;
        void* kargs[] = {&a};
        const hipError_t e = hipLaunchCooperativeKernel((const void*)mk_fwd, dim3(grid), dim3(NWAVES * 64), kargs, LDS_BYTES, stream);
        if (e != hipSuccess) fprintf(stderr, "kernel_launch: cooperative launch failed: %s (grid %d)\n", hipGetErrorString(e), grid);
    } else {
        for (int li = 0; li < PER_PHASE; ++li) {
            a.ph_lo = li; a.ph_hi = li + 1; a.li = li;
            hipLaunchKernelGGL(mk_fwd, dim3(grid), dim3(NWAVES * 64), LDS_BYTES, stream, a);
        }
        const hipError_t le = hipPeekAtLastError();
        if (le != hipSuccess) fprintf(stderr, "kernel_launch: launch failed: %s\n", hipGetErrorName(le));
    }
}
```

```cpp
#include <hip/hip_runtime.h>
#include <hip/hip_cooperative_groups.h>
#include <cstdio>
#include <cstdint>
namespace cg = cooperative_groups;

#ifndef MK_N_LAUNCHES
#define MK_N_LAUNCHES 1
#endif
#ifndef MK_CG_ALL
#define MK_CG_ALL 0
#endif

namespace pg8 {
#define PG8_LAS __attribute__((address_space(3)))
typedef unsigned short bf16_t;
typedef short bf16x8 __attribute__((ext_vector_type(8)));
typedef float f32x4 __attribute__((ext_vector_type(4)));
typedef unsigned u32x4 __attribute__((ext_vector_type(4)));
constexpr int BM = 256, BK = 64, HALF = 128, HTB = HALF * BK * 2, STAGE_BYTES = 8 * HTB, NXCD = 8, WGM = 8;

__host__ __device__ __forceinline__ int lds_byte(int r, int c) { const int st = (r >> 4) * 2 + (c >> 5), rr = r & 15, cc = c & 31, ob = rr * 64 + cc * 2; return st * 1024 + (ob ^ (((ob >> 9) & 1) << 5)); }
__host__ __device__ __forceinline__ void stage_rc(int b, int& R, int& C) { const int st = b / 1024, sb = b % 1024, swz = sb ^ (((sb >> 9) & 1) << 5); R = (st >> 1) * 16 + swz / 64; C = (st & 1) * 32 + (swz % 64) / 2; }
__host__ __device__ __forceinline__ int perm32(int rho) { const int n = rho >> 4, i = rho & 15; return 8 * (i >> 2) + 4 * n + (i & 3); }

struct Unit { int pm, pn; };
struct Gemm { const bf16_t* A; const bf16_t* Bt; int M, N, K; };

struct StaticOrder {
    int nM, nN, nwg, G, c;
    __host__ __device__ void init(int M, int N, int G_, int c_) { nM = M / BM; nN = N / BM; nwg = nM * nN; G = G_; c = c_; }
    __host__ __device__ bool next(int i, Unit& u) const {
        const long L = (long)i * G + c; if (L >= nwg) return false;
        int wgid = (int)L; { const int q = nwg / NXCD, r = nwg % NXCD, xcd = wgid % NXCD, off = wgid / NXCD; wgid = (xcd < r ? xcd * (q + 1) : r * (q + 1) + (xcd - r) * q) + off; }
        const int nig = WGM * nN, gid = wgid / nig, fm = gid * WGM, gsz = (nM - fm) < WGM ? (nM - fm) : WGM;
        u.pm = fm + ((wgid % nig) % gsz); u.pn = (wgid % nig) / gsz; return true;
    }
    __device__ __forceinline__ void a_ready(const Unit&) const {}
    __device__ __forceinline__ void done(const Unit&) const {}
};

__device__ __forceinline__ unsigned cvt_pk_bf16(float lo, float hi) { unsigned r; asm volatile("v_cvt_pk_bf16_f32 %0, %1, %2" : "=v"(r) : "v"(lo), "v"(hi)); return r;  }
__device__ __forceinline__ u32x4 pack8(f32x4 v0, f32x4 v1) { u32x4 w; w.x = cvt_pk_bf16(v0[0], v0[1]); w.y = cvt_pk_bf16(v0[2], v0[3]); w.z = cvt_pk_bf16(v1[0], v1[1]); w.w = cvt_pk_bf16(v1[2], v1[3]); return w; }
__device__ __forceinline__ float sq8(f32x4 a, f32x4 b) { return ((a[0] * a[0] + a[1] * a[1]) + (a[2] * a[2] + a[3] * a[3])) + ((b[0] * b[0] + b[1] * b[1]) + (b[2] * b[2] + b[3] * b[3])); }

struct EpiProj {
    static constexpr bool PERM = true, AFTER_DRAIN = false, MIDK = false;
    bf16_t *QA, *KA, *VA, *QB, *CKV, *KPE; float* ssq;
    __device__ __forceinline__ void midk(f32x4 (&)[2][2][4][2], int, int, PG8_LAS unsigned char*) const {}
    __device__ __forceinline__ void operator()(const f32x4 (&acc)[2][2][4][2], const Unit& u, int wr, int wc, int fr, int fq, PG8_LAS unsigned char*) const {
        const int pn = u.pn; bf16_t* base; int ldc, colt;
        if (pn < 4) { base = QA; ldc = 1024; colt = pn * 256; }
        else if (pn == 4) { base = KA; ldc = 256; colt = 0; }
        else if (pn == 5) { base = VA; ldc = 256; colt = 0; }
        else if (pn < 12) { base = QB; ldc = 1536; colt = (pn - 6) * 256; }
        else if (pn < 14) { base = CKV; ldc = 512; colt = (pn - 12) * 256; }
        else { base = KPE; ldc = 64; colt = 0; }
        const int row0 = u.pm * BM + wr * 64 + fr, lc0 = wc * 32 + 8 * fq;
        const bool kpe = (pn == 14), st0 = !kpe || (lc0 < 64), st1 = !kpe;
#pragma unroll
        for (int ai = 0; ai < 2; ++ai)
#pragma unroll
            for (int m = 0; m < 4; ++m) { const int row = row0 + ai * HALF + m * 16; bf16_t* rowp = base + (size_t)row * ldc + colt + lc0;
                if (st0) *(u32x4*)(rowp) = pack8(acc[ai][0][m][0], acc[ai][0][m][1]);
                if (st1) *(u32x4*)(rowp + HALF) = pack8(acc[ai][1][m][0], acc[ai][1][m][1]);
                if (pn == 12 || pn == 13) { float s = sq8(acc[ai][0][m][0], acc[ai][0][m][1]) + sq8(acc[ai][1][m][0], acc[ai][1][m][1]);
                    s += __shfl_xor(s, 16); s += __shfl_xor(s, 32);
                    if (fq == 0) ssq[(size_t)row * 8 + (pn - 12) * 4 + wc] = s; } }
    }
};
struct EpiKvb {
    static constexpr bool PERM = true, AFTER_DRAIN = false, MIDK = false;
    bf16_t* O; const float* ssq;
    __device__ __forceinline__ void midk(f32x4 (&)[2][2][4][2], int, int, PG8_LAS unsigned char*) const {}
    __device__ __forceinline__ void operator()(const f32x4 (&acc)[2][2][4][2], const Unit& u, int wr, int wc, int fr, int fq, PG8_LAS unsigned char*) const {
        const int row0 = u.pm * BM + wr * 64 + fr, col0 = u.pn * BM + wc * 32 + 8 * fq;
#pragma unroll
        for (int ai = 0; ai < 2; ++ai)
#pragma unroll
            for (int m = 0; m < 4; ++m) { const int row = row0 + ai * HALF + m * 16;
                const f32x4 a = *(const f32x4*)(ssq + (size_t)row * 8), b = *(const f32x4*)(ssq + (size_t)row * 8 + 4);
                const float inv = 1.0f / sqrtf((((a[0] + a[1]) + (a[2] + a[3])) + ((b[0] + b[1]) + (b[2] + b[3]))) * (1.0f / 512.0f) + 1e-6f);
                bf16_t* rowp = O + (size_t)row * 2048 + col0;
                *(u32x4*)(rowp) = pack8(acc[ai][0][m][0] * inv, acc[ai][0][m][1] * inv);
                *(u32x4*)(rowp + HALF) = pack8(acc[ai][1][m][0] * inv, acc[ai][1][m][1] * inv); }
    }
};
template <int ACT  , bool ROWSCALE, bool SSQ> struct EpiGen {
    static constexpr bool PERM = true, AFTER_DRAIN = false, MIDK = ROWSCALE;
    bf16_t* O; int ldc; float* ssq;
    int nssq;
    __device__ __forceinline__ void midk(f32x4 (&acc)[2][2][4][2], int wr, int fr, PG8_LAS unsigned char* tab) const {
        if constexpr (ROWSCALE) {
            const PG8_LAS float* T = (const PG8_LAS float*)tab;
#pragma unroll
            for (int ai = 0; ai < 2; ++ai)
#pragma unroll
                for (int m = 0; m < 4; ++m) { const float r = T[ai * HALF + wr * 64 + m * 16 + fr];
#pragma unroll
                    for (int bj = 0; bj < 2; ++bj)
#pragma unroll
                        for (int n = 0; n < 2; ++n) acc[ai][bj][m][n] = acc[ai][bj][m][n] * r; }
        }
    }
    __device__ __forceinline__ void operator()(const f32x4 (&acc)[2][2][4][2], const Unit& u, int wr, int wc, int fr, int fq, PG8_LAS unsigned char* tab) const {
        const int row0 = u.pm * BM + wr * 64 + fr, col0 = u.pn * BM + wc * 32 + 8 * fq;
        const PG8_LAS float* T = (const PG8_LAS float*)tab;
#pragma unroll
        for (int ai = 0; ai < 2; ++ai)
#pragma unroll
            for (int m = 0; m < 4; ++m) { const int row = row0 + ai * HALF + m * 16;
                float sc = 1.0f; if constexpr (ROWSCALE) sc = T[256 + ai * HALF + wr * 64 + m * 16 + fr];
                f32x4 v[2][2];
#pragma unroll
                for (int bj = 0; bj < 2; ++bj)
#pragma unroll
                    for (int n = 0; n < 2; ++n) { f32x4 x = acc[ai][bj][m][n];
                        if constexpr (ROWSCALE) x = x * sc;
                        if constexpr (ACT == 1) { x[0] = fmaxf(x[0], 0.f); x[1] = fmaxf(x[1], 0.f); x[2] = fmaxf(x[2], 0.f); x[3] = fmaxf(x[3], 0.f); x = x * x; }
                        v[bj][n] = x; }
                bf16_t* rowp = O + (size_t)row * ldc + col0;
                *(u32x4*)(rowp) = pack8(v[0][0], v[0][1]);
                *(u32x4*)(rowp + HALF) = pack8(v[1][0], v[1][1]);
                if constexpr (SSQ) { float s = sq8(v[0][0], v[0][1]) + sq8(v[1][0], v[1][1]);
                    s += __shfl_xor(s, 16); s += __shfl_xor(s, 32);
                    if (fq == 0) ssq[(size_t)row * nssq + u.pn * 4 + wc] = s; } }
    }
};

template <class Epi, class Sched, bool ALIGN_EPI = false, bool SP2 = false>
__device__ __forceinline__ void gemm_phase(PG8_LAS unsigned char* lds, PG8_LAS unsigned char* tab, const Gemm g, const Sched& S, const Epi& E, const int tid, const int wid  ) {
    const int lane = tid & 63, wr = wid >> 2, wc = wid & 3, fr = lane & 15, fq = lane >> 4;
    const int K = g.K, nt = K / BK;
    unsigned voffA[2], voffB[2];
#pragma unroll
    for (int i = 0; i < 2; ++i) { int R, C; stage_rc(tid * 16 + i * 8192, R, C); const int Rb = Epi::PERM ? ((R & ~31) + perm32(R & 31)) : R;
        voffA[i] = (unsigned)(R * K + C) * 2u; voffB[i] = (unsigned)(Rb * K + C) * 2u; }
    const size_t kstep = (size_t)(BK * 2);
    const size_t hstep = (size_t)HALF * K * 2;
    const size_t tstep = 2 * hstep;
    const unsigned ldsw = (unsigned)wid * 1024u;
    const int aoff = lds_byte(wr * 64 + fr, fq * 8), boff = lds_byte(wc * 32 + fr, fq * 8);
#define PG8_SA(b, h) (((b) * 2 + (h)) * HTB)
#define PG8_SB(b, h) ((4 + (b) * 2 + (h)) * HTB)
#define PG8_STAGE(bufoff, gbase, voff) do { _Pragma("unroll") for (int _i = 0; _i < 2; ++_i) \
        __builtin_amdgcn_global_load_lds((const unsigned*)((const char*)(gbase) + (voff)[_i]), (PG8_LAS unsigned*)(lds + (bufoff) + ldsw + _i * 8192), 16, 0, 0); } while (0)
#define PG8_LDA(dst, b, h) do { _Pragma("unroll") for (int m = 0; m < 4; ++m) _Pragma("unroll") for (int k = 0; k < 2; ++k) dst[m][k] = *(const PG8_LAS bf16x8*)(lds + PG8_SA(b, h) + aoff + m * 2048 + k * 1024); } while (0)
#define PG8_LDB(dst, b, h) do { _Pragma("unroll") for (int n = 0; n < 2; ++n) _Pragma("unroll") for (int k = 0; k < 2; ++k) dst[n][k] = *(const PG8_LAS bf16x8*)(lds + PG8_SB(b, h) + boff + n * 2048 + k * 1024); } while (0)
#define PG8_MMA(ai, bj, At, Bt) do { __builtin_amdgcn_s_setprio(1); _Pragma("unroll") for (int m = 0; m < 4; ++m) _Pragma("unroll") for (int n = 0; n < 2; ++n) _Pragma("unroll") for (int k = 0; k < 2; ++k) \
        acc[ai][bj][m][n] = __builtin_amdgcn_mfma_f32_16x16x32_bf16(Bt[n][k], At[m][k], acc[ai][bj][m][n], 0, 0, 0); __builtin_amdgcn_s_setprio(0); } while (0)
#define PG8_WAIT_V(n) asm volatile("s_waitcnt vmcnt(" #n ")" ::: "memory")
#define PG8_WAIT_L(n) asm volatile("s_waitcnt lgkmcnt(" #n ")" ::: "memory")
#define PG8_BAR __builtin_amdgcn_s_barrier()
#define PG8_SCHED __builtin_amdgcn_sched_barrier(0)
    Unit cur, nxt; int ui = 0;
    if (!S.next(0, cur)) return;
    f32x4 acc[2][2][4][2];
#pragma unroll
    for (int a = 0; a < 2; ++a)
#pragma unroll
        for (int b = 0; b < 2; ++b)
#pragma unroll
            for (int m = 0; m < 4; ++m)
#pragma unroll
                for (int n = 0; n < 2; ++n) acc[a][b][m][n] = (f32x4){0.f, 0.f, 0.f, 0.f};
    bf16x8 At[4][2], B0[2][2], B1[2][2];
    const char* cA = (const char*)g.A + (size_t)cur.pm * tstep; const char* cB = (const char*)g.Bt + (size_t)cur.pn * tstep;
    S.a_ready(cur);
    if constexpr (SP2) {
        PG8_STAGE(PG8_SB(0, 0), cB, voffB); PG8_STAGE(PG8_SB(0, 1), cB + hstep, voffB); PG8_STAGE(PG8_SA(0, 0), cA, voffA); PG8_STAGE(PG8_SA(0, 1), cA + hstep, voffA);
        if (wr == 1) PG8_BAR;
        PG8_WAIT_V(2); PG8_BAR;
        PG8_STAGE(PG8_SB(1, 0), cB + kstep, voffB); PG8_STAGE(PG8_SA(1, 0), cA + kstep, voffA); PG8_STAGE(PG8_SB(1, 1), cB + hstep + kstep, voffB);
        PG8_WAIT_V(6); PG8_BAR;
    } else {
        PG8_STAGE(PG8_SB(0, 0), cB, voffB); PG8_STAGE(PG8_SA(0, 0), cA, voffA); PG8_STAGE(PG8_SB(0, 1), cB + hstep, voffB); PG8_STAGE(PG8_SA(0, 1), cA + hstep, voffA);
        if (wr == 1) PG8_BAR;
        PG8_WAIT_V(4); PG8_BAR;
        PG8_STAGE(PG8_SB(1, 0), cB + kstep, voffB); PG8_STAGE(PG8_SA(1, 0), cA + kstep, voffA); PG8_STAGE(PG8_SB(1, 1), cB + hstep + kstep, voffB);
        PG8_WAIT_V(6); PG8_BAR;
    }
    for (;;) {
        const bool has_next = S.next(ui + 1, nxt);
        const char* nA = has_next ? (const char*)g.A + (size_t)nxt.pm * tstep : cA; const char* nB = has_next ? (const char*)g.Bt + (size_t)nxt.pn * tstep : cB;
        for (int t = 0; t < nt; t += 2) {
            if constexpr (Epi::MIDK) { if (t == (nt >> 1)) E.midk(acc, wr, fr, tab); }
            const bool last = (t == nt - 2);
            const char* a1 = cA + (size_t)(t + 1) * kstep;
            const char* a2 = last ? nA : cA + (size_t)(t + 2) * kstep; const char* b2 = last ? nB : cB + (size_t)(t + 2) * kstep;
            const char* a3 = a2 + kstep; const char* b3 = b2 + kstep;
            if (last && has_next) S.a_ready(nxt);
            if constexpr (SP2) {
            PG8_LDB(B0, 0, 0); PG8_LDB(B1, 0, 1); PG8_SCHED; PG8_LDA(At, 0, 0); PG8_STAGE(PG8_SA(1, 1), a1 + hstep, voffA);
            PG8_WAIT_V(8); PG8_WAIT_L(0); PG8_BAR; PG8_MMA(0, 0, At, B0); PG8_MMA(0, 1, At, B1); PG8_BAR; PG8_SCHED;
            PG8_LDA(At, 0, 1); PG8_STAGE(PG8_SB(0, 0), b2, voffB); PG8_STAGE(PG8_SB(0, 1), b2 + hstep, voffB); PG8_STAGE(PG8_SA(0, 0), a2, voffA);
            PG8_WAIT_V(8); PG8_WAIT_L(0); PG8_BAR; PG8_MMA(1, 0, At, B0); PG8_MMA(1, 1, At, B1); PG8_BAR; PG8_SCHED;
            PG8_LDB(B0, 1, 0); PG8_LDB(B1, 1, 1); PG8_SCHED; PG8_LDA(At, 1, 0); PG8_STAGE(PG8_SA(0, 1), a2 + hstep, voffA);
            PG8_WAIT_V(8); PG8_WAIT_L(0); PG8_BAR; PG8_MMA(0, 0, At, B0); PG8_MMA(0, 1, At, B1); PG8_BAR; PG8_SCHED;
            PG8_LDA(At, 1, 1); PG8_STAGE(PG8_SB(1, 0), b3, voffB); PG8_STAGE(PG8_SB(1, 1), b3 + hstep, voffB); PG8_STAGE(PG8_SA(1, 0), a3, voffA);
            PG8_WAIT_V(8); PG8_WAIT_L(0); PG8_BAR; PG8_MMA(1, 0, At, B0); PG8_MMA(1, 1, At, B1); PG8_BAR; PG8_SCHED;
            } else {
            PG8_LDB(B0, 0, 0); PG8_SCHED; PG8_LDA(At, 0, 0); PG8_STAGE(PG8_SA(1, 1), a1 + hstep, voffA);
            PG8_WAIT_L(8); PG8_BAR; PG8_WAIT_L(0); PG8_MMA(0, 0, At, B0); PG8_BAR; PG8_SCHED;
            PG8_LDB(B1, 0, 1); PG8_STAGE(PG8_SB(0, 0), b2, voffB);
            PG8_BAR; PG8_WAIT_L(0); PG8_MMA(0, 1, At, B1); PG8_BAR;
            PG8_LDA(At, 0, 1); PG8_STAGE(PG8_SA(0, 0), a2, voffA);
            PG8_BAR; PG8_WAIT_L(0); PG8_MMA(1, 0, At, B0); PG8_BAR; PG8_SCHED;
            PG8_STAGE(PG8_SB(0, 1), b2 + hstep, voffB);
            PG8_WAIT_V(6); PG8_BAR; PG8_MMA(1, 1, At, B1); PG8_BAR;
            PG8_LDB(B0, 1, 0); PG8_SCHED; PG8_LDA(At, 1, 0); PG8_STAGE(PG8_SA(0, 1), a2 + hstep, voffA);
            PG8_WAIT_L(8); PG8_BAR; PG8_WAIT_L(0); PG8_MMA(0, 0, At, B0); PG8_BAR; PG8_SCHED;
            PG8_LDB(B1, 1, 1); PG8_STAGE(PG8_SB(1, 0), b3, voffB);
            PG8_BAR; PG8_WAIT_L(0); PG8_MMA(0, 1, At, B1); PG8_BAR;
            PG8_LDA(At, 1, 1); PG8_STAGE(PG8_SA(1, 0), a3, voffA);
            PG8_BAR; PG8_WAIT_L(0); PG8_MMA(1, 0, At, B0); PG8_BAR; PG8_SCHED;
            PG8_STAGE(PG8_SB(1, 1), b3 + hstep, voffB);
            PG8_WAIT_V(6); PG8_BAR; PG8_MMA(1, 1, At, B1); PG8_BAR;
            }
        }
        if constexpr (ALIGN_EPI) { if (wr == 0) PG8_BAR; }
        E(acc, cur, wr, wc, fr, fq, tab); S.done(cur);
        if (!has_next) break;
#pragma unroll
        for (int a = 0; a < 2; ++a)
#pragma unroll
            for (int b = 0; b < 2; ++b)
#pragma unroll
                for (int m = 0; m < 4; ++m)
#pragma unroll
                    for (int n = 0; n < 2; ++n) acc[a][b][m][n] = (f32x4){0.f, 0.f, 0.f, 0.f};
        cur = nxt; cA = nA; cB = nB; ++ui;
        if constexpr (ALIGN_EPI) { if (wr == 1) PG8_BAR; }
    }
    PG8_WAIT_V(0);
    if constexpr (!ALIGN_EPI) { if (wr == 0) PG8_BAR; }
    PG8_BAR;
#undef PG8_SA
#undef PG8_SB
#undef PG8_STAGE
#undef PG8_LDA
#undef PG8_LDB
#undef PG8_MMA
#undef PG8_WAIT_V
#undef PG8_WAIT_L
#undef PG8_BAR
#undef PG8_SCHED
}
}

#define PG8_SP2 true
#define PG8_ALIGN true

namespace attn {
typedef unsigned short bf16_t;
using bf16x8 = __attribute__((ext_vector_type(8))) short;
using s16x4  = __attribute__((ext_vector_type(4))) short;
using f32x16 = __attribute__((ext_vector_type(16))) float;
using u32x4  = __attribute__((ext_vector_type(4))) unsigned;
constexpr int NW = 8, QBLK = 32, KVBLK = 64;
constexpr int SHM_V = KVBLK * 128 * 2, SHM_K = KVBLK * 128 * 2, SHM_KP = KVBLK * 64 * 2;
constexpr int OFF_V = 0, OFF_K = 2 * SHM_V, OFF_WS = OFF_K + 2 * SHM_K, OFF_KP = OFF_WS + NW * 64 * 4, LDS_BYTES = OFF_KP + 2 * SHM_KP;
constexpr float THR = 8.f;
#define KSWZ(row, colB) ((row) * 256 + ((colB) ^ (((row) & 7) << 4)))
#define KPSWZ(row, colB) ((row) * 128 + ((colB) ^ (((row) & 7) << 4)))
#define SBAR() __builtin_amdgcn_sched_barrier(0)
__device__ __forceinline__ int crow(int r, int hi) { return (r & 3) + 8 * (r >> 2) + 4 * hi; }
__device__ __forceinline__ unsigned cvtpk(float lo, float hi) { unsigned r; asm volatile("v_cvt_pk_bf16_f32 %0, %1, %2" : "=v"(r) : "v"(lo), "v"(hi)); return r; }
__device__ __forceinline__ bf16x8 ld8(const bf16_t* p) { return *reinterpret_cast<const bf16x8*>(p); }

template <int DQK> struct Cst { static constexpr float SCALE = (DQK == 128) ? 0.088388347648318440f : 0.072168783648703220f; };

template <int DQK>
__device__ __forceinline__ void partialSM(f32x16& p0, f32x16& p1, float& m_reg, float& mn, float& alpha) {
  constexpr float SCALE = Cst<DQK>::SCALE, C = SCALE * 1.4426950408889634f;
  float pmax = p0[0];
#pragma unroll
  for (int r = 1; r < 16; ++r) pmax = fmaxf(pmax, p0[r]);
#pragma unroll
  for (int r = 0; r < 16; ++r) pmax = fmaxf(pmax, p1[r]);
  { auto rr = __builtin_amdgcn_permlane32_swap(__float_as_uint(pmax), __float_as_uint(pmax), false, false);
    pmax = fmaxf(__uint_as_float(rr[0]), __uint_as_float(rr[1])); }
  if (__builtin_expect(__all(pmax - m_reg <= THR / SCALE), 1)) { mn = m_reg; alpha = 1.f; }
  else { mn = fmaxf(m_reg, pmax); alpha = __builtin_amdgcn_exp2f((m_reg - mn) * C); m_reg = mn; }
  float mnC = -mn * C;
#pragma unroll
  for (int r = 0; r < 16; ++r) p0[r] = fmaf(p0[r], C, mnC);
#pragma unroll
  for (int r = 0; r < 16; ++r) p1[r] = fmaf(p1[r], C, mnC);
#pragma unroll
  for (int r = 0; r < 16; ++r) p0[r] = __builtin_amdgcn_exp2f(p0[r]);
}
__device__ __forceinline__ void finishSM(f32x16& p0, f32x16& p1, float alpha, float& l_reg, bf16x8& pa0, bf16x8& pa1, bf16x8& pa2, bf16x8& pa3) {
#pragma unroll
  for (int r = 0; r < 16; ++r) p1[r] = __builtin_amdgcn_exp2f(p1[r]);
  float ps = 0;
#pragma unroll
  for (int r = 0; r < 16; ++r) ps += p0[r];
#pragma unroll
  for (int r = 0; r < 16; ++r) ps += p1[r];
  { auto rr = __builtin_amdgcn_permlane32_swap(__float_as_uint(ps), __float_as_uint(ps), false, false);
    ps = __uint_as_float(rr[0]) + __uint_as_float(rr[1]); }
  l_reg = l_reg * alpha + ps;
#define PK4(P, BASE, OUT) do { unsigned a0 = cvtpk(P[BASE + 0], P[BASE + 1]), a1 = cvtpk(P[BASE + 2], P[BASE + 3]);   \
    unsigned b0 = cvtpk(P[BASE + 4], P[BASE + 5]), b1 = cvtpk(P[BASE + 6], P[BASE + 7]);                              \
    auto r0 = __builtin_amdgcn_permlane32_swap(a0, b0, false, false); auto r1 = __builtin_amdgcn_permlane32_swap(a1, b1, false, false); \
    u32x4 w = {r0[0], r1[0], r0[1], r1[1]}; OUT = *reinterpret_cast<bf16x8*>(&w); } while (0)
  PK4(p0, 0, pa0); PK4(p0, 8, pa1); PK4(p1, 0, pa2); PK4(p1, 8, pa3);
#undef PK4
}
template <int DQK>
__device__ __forceinline__ void qkt(f32x16& p0, f32x16& p1, const char* Ks, const char* Kps, const bf16x8* qr, int r32, int hi) {
  p0 = f32x16{}; p1 = f32x16{};
#pragma unroll
  for (int d0 = 0; d0 < 8; ++d0) { int cb = (d0 * 16 + hi * 8) * 2;
    bf16x8 b0 = *reinterpret_cast<const bf16x8*>(Ks + KSWZ(r32, cb));
    bf16x8 b1 = *reinterpret_cast<const bf16x8*>(Ks + KSWZ(32 + r32, cb));
    p0 = __builtin_amdgcn_mfma_f32_32x32x16_bf16(b0, qr[d0], p0, 0, 0, 0);
    p1 = __builtin_amdgcn_mfma_f32_32x32x16_bf16(b1, qr[d0], p1, 0, 0, 0); }
  if constexpr (DQK == 192) {
#pragma unroll
    for (int d0 = 0; d0 < 4; ++d0) { int cb = (d0 * 16 + hi * 8) * 2;
      bf16x8 b0 = *reinterpret_cast<const bf16x8*>(Kps + KPSWZ(r32, cb));
      bf16x8 b1 = *reinterpret_cast<const bf16x8*>(Kps + KPSWZ(32 + r32, cb));
      p0 = __builtin_amdgcn_mfma_f32_32x32x16_bf16(b0, qr[8 + d0], p0, 0, 0, 0);
      p1 = __builtin_amdgcn_mfma_f32_32x32x16_bf16(b1, qr[8 + d0], p1, 0, 0, 0); }
  }
}
__device__ __forceinline__ int v_st(int k, int c) { const int kk = (k & ~0xC) | ((k & 4) << 1) | ((k & 8) >> 1); return ((kk >> 3) * 4 + (c >> 5)) * 512 + ((kk & 7) * 32 + (c & 31)) * 2; }
__device__ __forceinline__ int v_rd_base(int lane) { return ((lane & 3) << 3) | (((lane >> 2) & 3) << 6) | (((lane >> 4) & 1) << 5) | (((lane >> 5) & 1) << 8); }
constexpr int v_rd_off(int d0, int ks, int half) { return d0 * 512 + ks * 4096 + half * 2048; }
template <int OFF> __device__ __forceinline__ s16x4 tr_read(int vb) {
  s16x4 r; asm volatile("ds_read_b64_tr_b16 %0, %1 offset:%2" : "=&v"(r) : "v"(vb), "i"(OFF) : "memory"); return r;
}
template <int D0> __device__ __forceinline__ void pv_one(f32x16& od, int vb, bf16x8 pa0, bf16x8 pa1, bf16x8 pa2, bf16x8 pa3) {
  const s16x4 l0 = tr_read<v_rd_off(D0, 0, 0)>(vb), h0 = tr_read<v_rd_off(D0, 0, 1)>(vb), l1 = tr_read<v_rd_off(D0, 1, 0)>(vb), h1 = tr_read<v_rd_off(D0, 1, 1)>(vb);
  const s16x4 l2 = tr_read<v_rd_off(D0, 2, 0)>(vb), h2 = tr_read<v_rd_off(D0, 2, 1)>(vb), l3 = tr_read<v_rd_off(D0, 3, 0)>(vb), h3 = tr_read<v_rd_off(D0, 3, 1)>(vb);
  asm volatile("s_waitcnt lgkmcnt(0)" ::: "memory"); SBAR();
#define PK(L, H) (bf16x8){L[0], L[1], L[2], L[3], H[0], H[1], H[2], H[3]}
  od = __builtin_amdgcn_mfma_f32_32x32x16_bf16(pa0, PK(l0, h0), od, 0, 0, 0);
  od = __builtin_amdgcn_mfma_f32_32x32x16_bf16(pa1, PK(l1, h1), od, 0, 0, 0);
  od = __builtin_amdgcn_mfma_f32_32x32x16_bf16(pa2, PK(l2, h2), od, 0, 0, 0);
  od = __builtin_amdgcn_mfma_f32_32x32x16_bf16(pa3, PK(l3, h3), od, 0, 0, 0);
#undef PK
}
__device__ __forceinline__ void pv_d0(f32x16* o, int vb, bf16x8 pa0, bf16x8 pa1, bf16x8 pa2, bf16x8 pa3) {
  pv_one<0>(o[0], vb, pa0, pa1, pa2, pa3); pv_one<1>(o[1], vb, pa0, pa1, pa2, pa3); pv_one<2>(o[2], vb, pa0, pa1, pa2, pa3); pv_one<3>(o[3], vb, pa0, pa1, pa2, pa3);
}

template <int DQK, int SDEPTH, int LDQ, int LDKN, int LDV>
__device__ __forceinline__ void attn_unit(const bf16_t* __restrict__ Qb, const bf16_t* __restrict__ Kn, const bf16_t* __restrict__ Kp, const bf16_t* __restrict__ Vh,
                                          bf16_t* __restrict__ Ob, float* __restrict__ ssq, int seq, char* lds, int wid_s) {
  constexpr int NQ = DQK / 16;
  unsigned z_s = 0u; asm volatile("" : "+v"(z_s));
  const int lane = __builtin_amdgcn_mbcnt_hi(~0u, __builtin_amdgcn_mbcnt_lo(~0u, z_s)), wid = wid_s, tid = wid_s * 64 + lane, r32 = lane & 31, hi = lane >> 5;
  char* V_lds = lds + OFF_V; char* K_lds = lds + OFF_K; char* Kp_lds = lds + OFF_KP;
  float* ws = (float*)(lds + OFF_WS) + wid * 64; float* li_l = ws; float* al_l = ws + 32;
  float m_reg = -1e30f, l_reg = 0; f32x16 o[4] = {}; bf16x8 qr[NQ];
  const bf16_t* Qw = Qb + (long)(wid * QBLK + r32) * LDQ + hi * 8;
#pragma unroll
  for (int d0 = 0; d0 < NQ; ++d0) qr[d0] = ld8(Qw + d0 * 16);
  const int sr = tid >> 4, sc = (tid & 15) * 8, vst0 = v_st(sr, sc), vst1 = v_st(32 + sr, sc);
  const int pr = tid >> 3, pc = (tid & 7) * 8;
  const int vb0 = (int)(uintptr_t)V_lds + v_rd_base(lane);
  struct { bf16x8 vs0, vs1, ks0, ks1, kp; } sr_[SDEPTH];
#define SLOAD(i, k0) do { sr_[i].vs0 = ld8(&Vh[(long)((k0) + sr) * LDV + sc]); sr_[i].vs1 = ld8(&Vh[(long)((k0) + 32 + sr) * LDV + sc]); \
    sr_[i].ks0 = ld8(&Kn[(long)((k0) + sr) * LDKN + sc]); sr_[i].ks1 = ld8(&Kn[(long)((k0) + 32 + sr) * LDKN + sc]); \
    if constexpr (DQK == 192) sr_[i].kp = ld8(&Kp[(long)((k0) + pr) * 64 + pc]); } while (0)
#define SWRITE(b, i) do { *(bf16x8*)(V_lds + (b) * SHM_V + vst0) = sr_[i].vs0;          \
    *(bf16x8*)(V_lds + (b) * SHM_V + vst1) = sr_[i].vs1; int kc = sc * 2;               \
    *(bf16x8*)(K_lds + (b) * SHM_K + KSWZ(sr, kc)) = sr_[i].ks0;                       \
    *(bf16x8*)(K_lds + (b) * SHM_K + KSWZ(32 + sr, kc)) = sr_[i].ks1;                  \
    if constexpr (DQK == 192) *(bf16x8*)(Kp_lds + (b) * SHM_KP + KPSWZ(pr, pc * 2)) = sr_[i].kp; } while (0)
#define SWAIT() do { if constexpr (SDEPTH == 2) { if constexpr (DQK == 192) asm volatile("s_waitcnt vmcnt(5)" ::: "memory"); else asm volatile("s_waitcnt vmcnt(4)" ::: "memory"); } \
    else asm volatile("s_waitcnt vmcnt(0)" ::: "memory"); } while (0)
#define RESC(a) do { if (__any((a) < 1.f)) { if (hi == 0) al_l[r32] = (a); asm volatile("s_waitcnt lgkmcnt(0)" ::: "memory"); \
    _Pragma("unroll") for (int d = 0; d < 4; ++d) _Pragma("unroll") for (int r = 0; r < 16; ++r) o[d][r] *= al_l[crow(r, hi)]; } } while (0)
  f32x16 pA0, pA1, pB0, pB1; float mnA, mnB, alA, alB; bf16x8 pa0, pa1, pa2, pa3; const int NT = seq / KVBLK;
  constexpr int SE = 0, SO = SDEPTH - 1;
  SLOAD(SE, 0); asm volatile("s_waitcnt vmcnt(0)" ::: "memory"); SWRITE(0, SE); __syncthreads();
  qkt<DQK>(pA0, pA1, K_lds, Kp_lds, qr, r32, hi); partialSM<DQK>(pA0, pA1, m_reg, mnA, alA);
  SLOAD(SO, KVBLK); if constexpr (SDEPTH == 2) { if (2 < NT) SLOAD(SE, 2 * KVBLK); }
  SWAIT(); SWRITE(1, SO); __syncthreads();
  for (int j = 1; j + 1 < NT; j += 2) {
    SBAR(); qkt<DQK>(pB0, pB1, K_lds + SHM_K, Kp_lds + SHM_KP, qr, r32, hi);
    finishSM(pA0, pA1, alA, l_reg, pa0, pa1, pa2, pa3); SBAR();
    SLOAD(SO, (j + SDEPTH) * KVBLK); SBAR();
    pv_d0(o, vb0, pa0, pa1, pa2, pa3); partialSM<DQK>(pB0, pB1, m_reg, mnB, alB);
    __syncthreads(); SWAIT(); SWRITE(0, SE);
    RESC(alB); __syncthreads();
    SBAR(); qkt<DQK>(pA0, pA1, K_lds, Kp_lds, qr, r32, hi);
    finishSM(pB0, pB1, alB, l_reg, pa0, pa1, pa2, pa3); SBAR();
    if (SDEPTH == 1 || j + 3 < NT) SLOAD(SE, (j + 1 + SDEPTH) * KVBLK); SBAR();
    pv_d0(o, vb0 + (int)SHM_V, pa0, pa1, pa2, pa3); partialSM<DQK>(pA0, pA1, m_reg, mnA, alA);
    __syncthreads(); SWAIT(); SWRITE(1, SO);
    RESC(alA); __syncthreads();
  }
  SBAR(); qkt<DQK>(pB0, pB1, K_lds + SHM_K, Kp_lds + SHM_KP, qr, r32, hi);
  finishSM(pA0, pA1, alA, l_reg, pa0, pa1, pa2, pa3); SBAR();
  pv_d0(o, vb0, pa0, pa1, pa2, pa3); partialSM<DQK>(pB0, pB1, m_reg, mnB, alB);
  __syncthreads(); RESC(alB);
  finishSM(pB0, pB1, alB, l_reg, pa0, pa1, pa2, pa3); SBAR();
  pv_d0(o, vb0 + (int)SHM_V, pa0, pa1, pa2, pa3);
  unsigned z_e = 0u; asm volatile("" : "+v"(z_e));
  const int lane_e_ = __builtin_amdgcn_mbcnt_hi(~0u, __builtin_amdgcn_mbcnt_lo(~0u, z_e));
  const int lane_e = lane_e_, r32e = lane_e & 31, hie = lane_e >> 5;
  float* li_e = (float*)(lds + OFF_WS) + wid_s * 64;
  if (hie == 0) li_e[r32e] = l_reg; asm volatile("s_waitcnt lgkmcnt(0)" ::: "memory");
  __syncthreads();
  bf16_t* stg = (bf16_t*)(lds + wid_s * 8192);
#pragma unroll
  for (int r = 0; r < 16; ++r) { const int orow = crow(r, hie); const float rl = __builtin_amdgcn_rcpf(li_e[orow]);
#pragma unroll
    for (int d0 = 0; d0 < 4; ++d0) { const unsigned w = cvtpk(o[d0][r] * rl, 0.f); stg[orow * 128 + d0 * 32 + r32e] = (bf16_t)(w & 0xffffu); } }
  asm volatile("s_waitcnt lgkmcnt(0)" ::: "memory");
  bf16_t* Ow = Ob + (long)(wid_s * QBLK) * 2048; float* sw = ssq + (long)(wid_s * QBLK) * 16;
#pragma unroll
  for (int i = 0; i < 8; ++i) { const int row = i * 4 + (lane_e >> 4), ch = lane_e & 15;
    const u32x4 v = *(const u32x4*)(stg + row * 128 + ch * 8);
    float s = 0.f;
#pragma unroll
    for (int e = 0; e < 4; ++e) { const float a = __uint_as_float(v[e] << 16), b = __uint_as_float(v[e] & 0xffff0000u); s += a * a + b * b; }
    s += __int_as_float(__builtin_amdgcn_ds_bpermute((lane_e ^ 1) << 2, __float_as_int(s))); s += __int_as_float(__builtin_amdgcn_ds_bpermute((lane_e ^ 2) << 2, __float_as_int(s)));
    s += __int_as_float(__builtin_amdgcn_ds_bpermute((lane_e ^ 4) << 2, __float_as_int(s))); s += __int_as_float(__builtin_amdgcn_ds_bpermute((lane_e ^ 8) << 2, __float_as_int(s)));
    *(u32x4*)(Ow + (long)row * 2048 + ch * 8) = v;
    if (ch == 0) sw[row * 16] = s; }
  __syncthreads();
#undef SLOAD
#undef SWRITE
#undef SWAIT
#undef RESC
}
#undef KSWZ
#undef KPSWZ
#undef SBAR
}

constexpr int NWAVES = 8;
constexpr int N_LAUNCHES = MK_N_LAUNCHES;
constexpr int PER_PHASE = 10;
constexpr int BATCH = 4, SEQ = 2048, DM = 2048, M = BATCH * SEQ;
constexpr int W_IN = 3648, W_INP = 3840, DFF = 8192, NMODW = 6 * DM;
constexpr float EPS = 1e-6f;

constexpr size_t MiB = 1u << 20;
constexpr size_t WS_CTL = 0, CTL_ZERO_BYTES = 64 * 1024;
constexpr size_t WS_MOD = 1 * MiB;
constexpr size_t WS_TAB = WS_MOD + 256 * 1024;
constexpr size_t WS_SSQC = 2 * MiB;
constexpr size_t WS_SSQO = WS_SSQC + 256 * 1024;
constexpr size_t WS_SSQP = WS_SSQO + 512 * 1024;
constexpr size_t WS_SSQY = WS_SSQP + 1024 * 1024;
constexpr size_t WS_WIN = 6 * MiB, WS_WKVB = 21 * MiB, WS_WOUT = 23 * MiB, WS_W1 = 31 * MiB, WS_W2 = 63 * MiB;
constexpr size_t WS_XN = 95 * MiB;
constexpr size_t WS_QA = 127 * MiB, WS_KA = 143 * MiB, WS_VA = 147 * MiB, WS_QB = 151 * MiB, WS_CKV = 175 * MiB, WS_KPE = 183 * MiB;
constexpr size_t WS_KVB = 184 * MiB, WS_OCAT = 216 * MiB, WS_OPROJ = 248 * MiB;
constexpr size_t WS_ACT = 127 * MiB;
constexpr size_t WS_Y = 280 * MiB, WS_END = 312 * MiB;
static_assert(WS_SSQY + 1024 * 1024 <= WS_WIN && WS_ACT + (size_t)M * DFF * 2 <= WS_Y, "d_ws map");
constexpr int CW_BAR = 1024;

constexpr int RING_OFF = 0, RING_BYTES = 131072;
constexpr int TAB_OFF = RING_BYTES;
constexpr int LDSCTL_OFF = TAB_OFF + 2048, MISC_OFF = LDSCTL_OFF + 320;
constexpr int LDS_BYTES = 147456;
static_assert(MISC_OFF + 128 <= LDS_BYTES && attn::LDS_BYTES <= RING_BYTES, "LDS map");

#define GAS __attribute__((address_space(1)))
#define LAS __attribute__((address_space(3)))
typedef unsigned short bf16;
typedef unsigned v4u __attribute__((ext_vector_type(4)));
typedef unsigned v2u __attribute__((ext_vector_type(2)));
typedef float f32x4 __attribute__((ext_vector_type(4)));
typedef GAS unsigned gu32;
#define RLX_AGENT __ATOMIC_RELAXED, __HIP_MEMORY_SCOPE_AGENT
#define LDS_WAIT() asm volatile("s_waitcnt lgkmcnt(0)" ::: "memory")
__device__ __forceinline__ unsigned f2bf(float f) { unsigned u = __builtin_bit_cast(unsigned, f); return (u + 0x7fffu + ((u >> 16) & 1u)) >> 16; }
__device__ __forceinline__ unsigned pk2(float lo, float hi) { return f2bf(lo) | (f2bf(hi) << 16); }
__device__ __forceinline__ float bflo(unsigned w) { return __uint_as_float(w << 16); }
__device__ __forceinline__ float bfhi(unsigned w) { return __uint_as_float(w & 0xffff0000u); }

#define XB_TMO      128
#define XB_XCNT(j)  (256  + 64 * (j))
#define XB_XSUB(j)  (1280 + 64 * (j))
#define XB_XGEN(j)  (2304 + 64 * (j))
#define XB_TOP      3328
#define XB_TOPGEN   3392
#define XCD_BAR_WORDS 3456
#define XB_SPIN_CAP (1u << 18)
__device__ __forceinline__ unsigned xb_ld(unsigned* p)              { return __hip_atomic_load(p, __ATOMIC_RELAXED, __HIP_MEMORY_SCOPE_AGENT); }
__device__ __forceinline__ unsigned xb_add(unsigned* p, unsigned v) { return __hip_atomic_fetch_add(p, v, __ATOMIC_RELAXED, __HIP_MEMORY_SCOPE_AGENT); }
__device__ __forceinline__ unsigned xb_xcc_id() { return (unsigned)__builtin_amdgcn_s_getreg((3 << 11) | 20) & 0xFu; }
#define XB_SPIN(cond, bar) do { unsigned _sp = 0; while (cond) { __builtin_amdgcn_s_sleep(1); \
    if ((++_sp & 255u) == 0u) { if (xb_ld(&(bar)[XB_TMO])) break; if (_sp > XB_SPIN_CAP) { atomicAdd(&(bar)[XB_TMO], 1u); break; } } } } while (0)
struct XcdBarrier { unsigned* bar; unsigned x; volatile LAS unsigned* st; };
__device__ __forceinline__ XcdBarrier xcd_barrier_post(unsigned* bar, volatile LAS unsigned* st) {
    XcdBarrier b; b.bar = bar; b.x = xb_xcc_id(); b.st = st;
    if (threadIdx.x == 0) (void)xb_add(&bar[XB_XCNT(b.x)], 1u);
    return b;
}
__device__ __forceinline__ void xcd_barrier_complete(unsigned* bar, unsigned x, unsigned& nloc, unsigned& nx) {
    const unsigned G = gridDim.x * gridDim.y * gridDim.z;
    unsigned sum, cnt, mine, sp = 0u;
    for (;;) {
        sum = 0u; cnt = 0u; mine = 0u;
#pragma unroll
        for (unsigned j = 0; j < 16; ++j) { const unsigned c = xb_ld(&bar[XB_XCNT(j)]); sum += c; cnt += (c > 0u) ? 1u : 0u; mine = (j == x) ? c : mine; }
        if (sum == G) break;
        __builtin_amdgcn_s_sleep(1);
        if ((++sp & 255u) == 0u) { if (xb_ld(&bar[XB_TMO])) break; if (sp > XB_SPIN_CAP) { atomicAdd(&bar[XB_TMO], 1u); break; } }
    }
    nloc = mine > 0u ? mine : 1u; nx = cnt > 0u ? cnt : 1u;
}
__device__ __forceinline__ void xcd_barrier(const XcdBarrier& b) {
    asm volatile("s_waitcnt vmcnt(0)" ::: "memory");
    __syncthreads();
    if (threadIdx.x == 0) {
        unsigned* bar = b.bar;
        __builtin_amdgcn_s_waitcnt(0);
        unsigned nloc = b.st[0], nx = b.st[1];
        if (nloc == 0u) { xcd_barrier_complete(bar, b.x, nloc, nx); b.st[0] = nloc; b.st[1] = nx; }
        const unsigned old = xb_add(&bar[XB_XSUB(b.x)], 1u);
        const unsigned gen = old / nloc;
        if (old + 1u == (gen + 1u) * nloc) {
            __builtin_amdgcn_fence(__ATOMIC_RELEASE, "agent");
            asm volatile("s_waitcnt vmcnt(0)" ::: "memory");
            const unsigned og = xb_add(&bar[XB_TOP], 1u);
            const unsigned tg = og / nx;
            if (og + 1u == (tg + 1u) * nx) xb_add(&bar[XB_TOPGEN], 1u);
            else XB_SPIN(xb_ld(&bar[XB_TOPGEN]) == tg, bar);
            __builtin_amdgcn_fence(__ATOMIC_ACQUIRE, "agent");
            xb_add(&bar[XB_XGEN(b.x)], 1u);
            asm volatile("s_waitcnt vmcnt(0)" ::: "memory");
        } else {
            XB_SPIN(xb_ld(&bar[XB_XGEN(b.x)]) == gen, bar);
            __builtin_amdgcn_fence(__ATOMIC_ACQUIRE, "agent");
            asm volatile("s_waitcnt vmcnt(0)" ::: "memory");
        }
    }
    __syncthreads();
}

struct Frame {
    LAS unsigned char* lds;
    volatile LAS unsigned* MISC;
    gu32* ctl;
    int tid, lane, wave;
    int vcu, G;
    const float *x, *c, *w_ada, *b_ada, *g_pre_attn, *w_in, *g_q_a, *g_k_a, *g_ckv, *w_kv_b, *g_out_a, *g_out_b, *w_out, *g_post_attn, *g_pre_mlp, *w_mlp_in, *w_mlp_out, *g_post_mlp;
    float* out;
    float *mod, *tab, *ssqc, *ssqo, *ssqp, *ssqy;
    bf16 *Win_t, *Wkvb_t, *Wout_t, *W1_t, *W2_t;
    bf16 *XN, *QA, *KA, *VA, *QB, *CKV, *KPE, *KVB, *OCAT, *OPROJ, *ACT, *Y;
};

__device__ __forceinline__ int fresh_lane() { unsigned z = 0u; asm volatile("" : "+v"(z)); return (int)__builtin_amdgcn_mbcnt_hi(~0u, __builtin_amdgcn_mbcnt_lo(~0u, z)); }
#define PHASE_BEGIN() do { F.lane = fresh_lane(); F.tid = F.wave * 64 + F.lane; } while (0)
__device__ __forceinline__ float wave_sum(float v) {
#pragma unroll
    for (int o = 1; o < 64; o <<= 1) v += __shfl_xor(v, o);
    return v;
}

__device__ __forceinline__ void p0_gemv_item(Frame& F, int j) {
    LAS float* sact = (LAS float*)(F.lds);
    LAS float* red = (LAS float*)(F.lds + 32768);
    for (int i = F.tid; i < 4 * DM; i += NWAVES * 64) { const float v = F.c[i]; sact[i] = v / (1.0f + expf(-v)); }
    __syncthreads();
    const int n0 = 64 * j, rsub = F.lane >> 4, c4 = (F.lane & 15) * 4;
    const float* wp = F.w_ada + (size_t)(256 * F.wave + rsub) * NMODW + n0 + c4;
    f32x4 a0 = {0.f, 0.f, 0.f, 0.f}, a1 = a0, a2 = a0, a3 = a0;
#pragma unroll 8
    for (int i = 0; i < 64; ++i) {
        const f32x4 wv = *(const f32x4*)(wp + (size_t)i * 4 * NMODW);
        const int k = 256 * F.wave + 4 * i + rsub;
        a0 += sact[k] * wv; a1 += sact[DM + k] * wv; a2 += sact[2 * DM + k] * wv; a3 += sact[3 * DM + k] * wv;
    }
#pragma unroll
    for (int e = 0; e < 4; ++e) {
        a0[e] += __shfl_xor(a0[e], 16); a0[e] += __shfl_xor(a0[e], 32);
        a1[e] += __shfl_xor(a1[e], 16); a1[e] += __shfl_xor(a1[e], 32);
        a2[e] += __shfl_xor(a2[e], 16); a2[e] += __shfl_xor(a2[e], 32);
        a3[e] += __shfl_xor(a3[e], 16); a3[e] += __shfl_xor(a3[e], 32);
    }
    if (rsub == 0) {
#pragma unroll
        for (int e = 0; e < 4; ++e) { red[(F.wave * 4 + 0) * 64 + c4 + e] = a0[e]; red[(F.wave * 4 + 1) * 64 + c4 + e] = a1[e]; red[(F.wave * 4 + 2) * 64 + c4 + e] = a2[e]; red[(F.wave * 4 + 3) * 64 + c4 + e] = a3[e]; }
    }
    __syncthreads();
    if (F.tid < 256) { const int b = F.tid >> 6, n = F.tid & 63; float s = 0.f;
#pragma unroll
        for (int w = 0; w < 8; ++w) s += red[(w * 4 + b) * 64 + n];
        F.mod[b * NMODW + n0 + n] = s + F.b_ada[n0 + n]; }
    __syncthreads();
}
__device__ __forceinline__ void p0_transpose_item(const float* W, int K, int N, bf16* WT, const float* ks, LAS float* scr, int item, int lane) {
    const int nblk = N / 32, kb = item / nblk, nb = item % nblk, k0 = 64 * kb, n0 = 32 * nb;
#pragma unroll 8
    for (int i = 0; i < 32; ++i) { const int kk = 2 * i + (lane >> 5); float v = W[(size_t)(k0 + kk) * N + n0 + (lane & 31)]; if (ks) v *= ks[k0 + kk]; scr[kk * 33 + (lane & 31)] = v; }
    LDS_WAIT(); asm volatile("" ::: "memory");
    const int c = lane & 7;
#pragma unroll
    for (int j = 0; j < 4; ++j) { const int n = (lane >> 3) + 8 * j; const LAS float* s = scr + (8 * c) * 33 + n;
        v4u o; o.x = pk2(s[0 * 33], s[1 * 33]); o.y = pk2(s[2 * 33], s[3 * 33]); o.z = pk2(s[4 * 33], s[5 * 33]); o.w = pk2(s[6 * 33], s[7 * 33]);
        *(GAS v4u*)(WT + (size_t)(n0 + n) * K + k0 + 8 * c) = o; }
    LDS_WAIT(); asm volatile("" ::: "memory");
}
__device__ __forceinline__ void p0_prologue(Frame& F) {
    const int bid = blockIdx.x;
    const bool gemvwg = bid < 192;
    if (gemvwg) p0_gemv_item(F, bid);
    if (bid == (int)gridDim.x - 1) {
        for (int idx = F.tid; idx < 64 * 32; idx += NWAVES * 64) { const int p = idx >> 5, i = idx & 31; const float inv = powf(10000.0f, -(float)(2 * i) / 64.0f); const float ang = (float)p * inv;
            F.tab[idx] = cosf(ang); F.tab[2048 + idx] = sinf(ang); }
        for (int idx = F.tid; idx < 64 * 16; idx += NWAVES * 64) { const int p = idx >> 4, i = idx & 15; const float inv = powf(10000.0f, -(float)(2 * i) / 32.0f); const float ang = (float)p * inv;
            F.tab[4096 + idx] = cosf(ang); F.tab[5120 + idx] = sinf(ang); }
    }
    LAS float* scr = (LAS float*)(F.lds + RING_OFF + F.wave * 16384);
    constexpr int I_IN = (DM / 64) * (W_IN / 32), I_KVB = (512 / 64) * (2048 / 32), I_OUT = (DM / 64) * (DM / 32), I_1 = (DM / 64) * (DFF / 32), I_2 = (DFF / 64) * (DM / 32);
    constexpr int NITEMS = I_IN + I_KVB + I_OUT + I_1 + I_2;
    int it, stride, limit;
    if ((int)gridDim.x == 256) {
        if (gemvwg) { it = bid * 8 + F.wave; stride = 1536; limit = 13824; }
        else { it = 13824 + (bid - 192) * 8 + F.wave; stride = 512; limit = NITEMS; }
    } else { it = bid * 8 + F.wave; stride = (int)gridDim.x * 8; limit = NITEMS; }
    for (; it < limit; it += stride) {
        int r = it;
        if (r < I_IN) { p0_transpose_item(F.w_in, DM, W_IN, F.Win_t, nullptr, scr, r, F.lane); continue; } r -= I_IN;
        if (r < I_KVB) { p0_transpose_item(F.w_kv_b, 512, 2048, F.Wkvb_t, F.g_ckv, scr, r, F.lane); continue; } r -= I_KVB;
        if (r < I_OUT) { const int kb = r / (DM / 32); const float* ks = (kb < 16) ? F.g_out_a : (F.g_out_b - 1024);
            p0_transpose_item(F.w_out, DM, DM, F.Wout_t, ks, scr, r, F.lane); continue; } r -= I_OUT;
        if (r < I_1) { p0_transpose_item(F.w_mlp_in, DM, DFF, F.W1_t, nullptr, scr, r, F.lane); continue; } r -= I_1;
        p0_transpose_item(F.w_mlp_out, DFF, DM, F.W2_t, nullptr, scr, r, F.lane);
    }
}
__device__ __forceinline__ void p1_rows(Frame& F) {
    const int gw = F.vcu * NWAVES + F.wave, NGW = F.G * NWAVES;
    for (int m = gw; m < M; m += NGW) {
        const int b = m >> 11; const float* sh = F.mod + b * NMODW; const float* scp = sh + DM;
        const f32x4* xr = (const f32x4*)(F.x + (size_t)m * DM) + F.lane;
        f32x4 v[8]; float s = 0.f;
#pragma unroll
        for (int j = 0; j < 8; ++j) { v[j] = xr[64 * j]; s += (v[j][0] * v[j][0] + v[j][1] * v[j][1]) + (v[j][2] * v[j][2] + v[j][3] * v[j][3]); }
        const float inv = 1.0f / sqrtf(wave_sum(s) * (1.0f / DM) + EPS);
        v2u* o8 = (v2u*)(F.XN + (size_t)m * DM) + F.lane;
#pragma unroll
        for (int j = 0; j < 8; ++j) { const int k = 4 * F.lane + 256 * j;
            const f32x4 g = *(const f32x4*)(F.g_pre_attn + k), sc = *(const f32x4*)(scp + k), sf = *(const f32x4*)(sh + k);
            const f32x4 h = v[j] * inv * g * (1.0f + sc) + sf;
            v2u w; w.x = pk2(h[0], h[1]); w.y = pk2(h[2], h[3]); o8[64 * j] = w; }
    }
}
__device__ __forceinline__ void p6_rows(Frame& F) {
    const int gw = F.vcu * NWAVES + F.wave, NGW = F.G * NWAVES;
    for (int m = gw; m < M; m += NGW) {
        const int b = m >> 11; const float* md = F.mod + b * NMODW; const float* gt = md + 2 * DM; const float* shm = md + 3 * DM; const float* scm = md + 4 * DM;
        const float ps = (F.lane < 32) ? F.ssqp[(size_t)m * 32 + F.lane] : 0.f;
        const float invo = 1.0f / sqrtf(wave_sum(ps) * (1.0f / DM) + EPS);
        const f32x4* xr = (const f32x4*)(F.x + (size_t)m * DM) + F.lane;
        const v2u* pr = (const v2u*)(F.OPROJ + (size_t)m * DM) + F.lane;
        f32x4* orow = (f32x4*)(F.out + (size_t)m * DM) + F.lane;
        f32x4 v[8]; float s = 0.f;
#pragma unroll
        for (int j = 0; j < 8; ++j) { const int k = 4 * F.lane + 256 * j;
            const v2u w = pr[64 * j]; const f32x4 op = {bflo(w.x), bfhi(w.x), bflo(w.y), bfhi(w.y)};
            const f32x4 g = *(const f32x4*)(F.g_post_attn + k), gg = *(const f32x4*)(gt + k);
            v[j] = xr[64 * j] + gg * (op * invo * g);
            orow[64 * j] = v[j];
            s += (v[j][0] * v[j][0] + v[j][1] * v[j][1]) + (v[j][2] * v[j][2] + v[j][3] * v[j][3]); }
        const float inv = 1.0f / sqrtf(wave_sum(s) * (1.0f / DM) + EPS);
        v2u* o8 = (v2u*)(F.XN + (size_t)m * DM) + F.lane;
#pragma unroll
        for (int j = 0; j < 8; ++j) { const int k = 4 * F.lane + 256 * j;
            const f32x4 g = *(const f32x4*)(F.g_pre_mlp + k), sc = *(const f32x4*)(scm + k), sf = *(const f32x4*)(shm + k);
            const f32x4 h = v[j] * inv * g * (1.0f + sc) + sf;
            v2u w; w.x = pk2(h[0], h[1]); w.y = pk2(h[2], h[3]); o8[64 * j] = w; }
    }
}
__device__ __forceinline__ void p9_rows(Frame& F) {
    const int gw = F.vcu * NWAVES + F.wave, NGW = F.G * NWAVES;
    for (int m = gw; m < M; m += NGW) {
        const int b = m >> 11; const float* gt = F.mod + b * NMODW + 5 * DM;
        const float ps = (F.lane < 32) ? F.ssqy[(size_t)m * 32 + F.lane] : 0.f;
        const float invy = 1.0f / sqrtf(wave_sum(ps) * (1.0f / DM) + EPS);
        const v2u* yr = (const v2u*)(F.Y + (size_t)m * DM) + F.lane;
        f32x4* orow = (f32x4*)(F.out + (size_t)m * DM) + F.lane;
#pragma unroll
        for (int j = 0; j < 8; ++j) { const int k = 4 * F.lane + 256 * j;
            const v2u w = yr[64 * j]; const f32x4 yv = {bflo(w.x), bfhi(w.x), bflo(w.y), bfhi(w.y)};
            const f32x4 g = *(const f32x4*)(F.g_post_mlp + k), gg = *(const f32x4*)(gt + k);
            orow[64 * j] = orow[64 * j] + gg * (yv * invy * g); }
    }
}
__device__ __forceinline__ void rope8(float (&x)[8], int j, int prow, int pcol, const float* tab) {
    const int pos = (j & 4) ? pcol : prow, fi0 = 8 * (j & 1); const float sgn = (j & 2) ? 1.f : -1.f;
    const float* ct = tab + 4096 + pos * 16 + fi0; const float* st = tab + 5120 + pos * 16 + fi0;
#pragma unroll
    for (int e = 0; e < 8; ++e) { const float part = __shfl_xor(x[e], 2); x[e] = x[e] * ct[e] + sgn * part * st[e]; }
}
__device__ __forceinline__ void normrope16(float (&x)[16], int j, int prow, int pcol, const float* g, const float* tab) {
    float ss = 0.f;
#pragma unroll
    for (int e = 0; e < 16; ++e) ss += x[e] * x[e];
    ss += __shfl_xor(ss, 1); ss += __shfl_xor(ss, 2); ss += __shfl_xor(ss, 4);
    const float inv = 1.0f / sqrtf(ss * (1.0f / 128.0f) + EPS);
    const int pos = (j & 4) ? pcol : prow, fi0 = 16 * (j & 1); const float sgn = (j & 2) ? 1.f : -1.f;
    const float* ct = tab + pos * 32 + fi0; const float* st = tab + 2048 + pos * 32 + fi0;
#pragma unroll
    for (int e = 0; e < 16; ++e) x[e] = x[e] * inv * g[16 * j + e];
#pragma unroll
    for (int e = 0; e < 16; ++e) { const float part = __shfl_xor(x[e], 2); x[e] = x[e] * ct[e] + sgn * part * st[e]; }
}
__device__ __forceinline__ void p3_fixup_rows(Frame& F) {
    const int gw = F.vcu * NWAVES + F.wave, NGW = F.G * NWAVES; const int l = F.lane, j = l & 7;
    for (int m = gw; m < M; m += NGW) {
        const int t = m & (SEQ - 1), prow = t >> 6, pcol = t & 63;
        {
            v4u* p = (v4u*)(F.QA + (size_t)m * 1024 + 16 * l); const v4u w0 = p[0], w1 = p[1]; float x[16];
#pragma unroll
            for (int e = 0; e < 4; ++e) { x[2 * e] = bflo(w0[e]); x[2 * e + 1] = bfhi(w0[e]); x[8 + 2 * e] = bflo(w1[e]); x[8 + 2 * e + 1] = bfhi(w1[e]); }
            normrope16(x, j, prow, pcol, F.g_q_a, F.tab);
            v4u o0, o1;
#pragma unroll
            for (int e = 0; e < 4; ++e) { o0[e] = pk2(x[2 * e], x[2 * e + 1]); o1[e] = pk2(x[8 + 2 * e], x[8 + 2 * e + 1]); }
            p[0] = o0; p[1] = o1;
        }
        {
            v4u* p = (v4u*)(F.KA + (size_t)m * 256 + 16 * (l & 15)); const v4u w0 = p[0], w1 = p[1]; float x[16];
#pragma unroll
            for (int e = 0; e < 4; ++e) { x[2 * e] = bflo(w0[e]); x[2 * e + 1] = bfhi(w0[e]); x[8 + 2 * e] = bflo(w1[e]); x[8 + 2 * e + 1] = bfhi(w1[e]); }
            normrope16(x, j, prow, pcol, F.g_k_a, F.tab);
            v4u o0, o1;
#pragma unroll
            for (int e = 0; e < 4; ++e) { o0[e] = pk2(x[2 * e], x[2 * e + 1]); o1[e] = pk2(x[8 + 2 * e], x[8 + 2 * e + 1]); }
            if (l < 16) { p[0] = o0; p[1] = o1; }
        }
        {
            v4u* p = (v4u*)(F.QB + (size_t)m * 1536 + 192 * (l >> 3) + 128 + 8 * j); const v4u w = p[0]; float x[8];
#pragma unroll
            for (int e = 0; e < 4; ++e) { x[2 * e] = bflo(w[e]); x[2 * e + 1] = bfhi(w[e]); }
            rope8(x, j, prow, pcol, F.tab);
            v4u o;
#pragma unroll
            for (int e = 0; e < 4; ++e) o[e] = pk2(x[2 * e], x[2 * e + 1]);
            p[0] = o;
        }
        {
            v4u* p = (v4u*)(F.KPE + (size_t)m * 64 + 8 * j); const v4u w = p[0]; float x[8];
#pragma unroll
            for (int e = 0; e < 4; ++e) { x[2 * e] = bflo(w[e]); x[2 * e + 1] = bfhi(w[e]); }
            rope8(x, j, prow, pcol, F.tab);
            v4u o;
#pragma unroll
            for (int e = 0; e < 4; ++e) o[e] = pk2(x[2 * e], x[2 * e + 1]);
            if (l < 8) p[0] = o;
        }
    }
}

struct Args { const float* in[18]; float* out; unsigned char* ws; int ph_lo, ph_hi, li, pad; };
__global__ void __launch_bounds__(NWAVES * 64, 2) mk_fwd(Args args) {
    extern __shared__ __attribute__((aligned(16))) unsigned char lds[];
    Frame F;
    F.lds = (LAS unsigned char*)lds;
    F.MISC = (volatile LAS unsigned*)(F.lds + MISC_OFF);
    F.tid = threadIdx.x; F.lane = F.tid & 63; F.wave = __builtin_amdgcn_readfirstlane(F.tid >> 6);
    F.G = gridDim.x; { const int bx = blockIdx.x; F.vcu = (F.G % 8 == 0) ? (bx % 8) * (F.G / 8) + bx / 8 : bx; }
    unsigned char* ws = args.ws;
    F.ctl = (gu32*)(ws + WS_CTL);
    F.x = args.in[0]; F.c = args.in[1]; F.w_ada = args.in[2]; F.b_ada = args.in[3]; F.g_pre_attn = args.in[4]; F.w_in = args.in[5]; F.g_q_a = args.in[6]; F.g_k_a = args.in[7];
    F.g_ckv = args.in[8]; F.w_kv_b = args.in[9]; F.g_out_a = args.in[10]; F.g_out_b = args.in[11]; F.w_out = args.in[12]; F.g_post_attn = args.in[13]; F.g_pre_mlp = args.in[14];
    F.w_mlp_in = args.in[15]; F.w_mlp_out = args.in[16]; F.g_post_mlp = args.in[17]; F.out = args.out;
    F.mod = (float*)(ws + WS_MOD); F.tab = (float*)(ws + WS_TAB); F.ssqc = (float*)(ws + WS_SSQC); F.ssqo = (float*)(ws + WS_SSQO); F.ssqp = (float*)(ws + WS_SSQP); F.ssqy = (float*)(ws + WS_SSQY);
    F.Win_t = (bf16*)(ws + WS_WIN); F.Wkvb_t = (bf16*)(ws + WS_WKVB); F.Wout_t = (bf16*)(ws + WS_WOUT); F.W1_t = (bf16*)(ws + WS_W1); F.W2_t = (bf16*)(ws + WS_W2);
    F.XN = (bf16*)(ws + WS_XN); F.QA = (bf16*)(ws + WS_QA); F.KA = (bf16*)(ws + WS_KA); F.VA = (bf16*)(ws + WS_VA); F.QB = (bf16*)(ws + WS_QB); F.CKV = (bf16*)(ws + WS_CKV); F.KPE = (bf16*)(ws + WS_KPE);
    F.KVB = (bf16*)(ws + WS_KVB); F.OCAT = (bf16*)(ws + WS_OCAT); F.OPROJ = (bf16*)(ws + WS_OPROJ); F.ACT = (bf16*)(ws + WS_ACT); F.Y = (bf16*)(ws + WS_Y);
    for (int u = F.tid; u < (LDS_BYTES - LDSCTL_OFF) / 4; u += NWAVES * 64) ((LAS unsigned*)(F.lds + LDSCTL_OFF))[u] = 0u;
    __syncthreads();
    XcdBarrier bar; bar.bar = (unsigned*)(F.ctl + CW_BAR); bar.x = 0; bar.st = nullptr;
    if (N_LAUNCHES == 1 && !MK_CG_ALL) bar = xcd_barrier_post((unsigned*)(F.ctl + CW_BAR), F.MISC + 8);
    const int lo = args.ph_lo, hi = args.ph_hi;
#ifndef PHMASK
#define PHMASK 0x3ff
#endif
#define IN(k) (((PHMASK >> (k)) & 1) && lo <= (k) && (k) < hi)
#define BOTH(k) (IN(k) && IN((k) + 1))
#define SEAM(k) do { if (BOTH(k)) { if (MK_CG_ALL || (k) == 0) cg::this_grid().sync(); else xcd_barrier(bar); } } while (0)

    if (IN(0)) { PHASE_BEGIN(); p0_prologue(F); SEAM(0); }
    if (IN(1)) { PHASE_BEGIN(); p1_rows(F); SEAM(1); }
    if (IN(2)) { PHASE_BEGIN();
        pg8::Gemm g{F.XN, F.Win_t, M, W_INP, DM}; pg8::StaticOrder S; S.init(M, W_INP, F.G, (int)blockIdx.x);
        pg8::EpiProj E{F.QA, F.KA, F.VA, F.QB, F.CKV, F.KPE, F.ssqc};
        pg8::gemm_phase<pg8::EpiProj, pg8::StaticOrder, PG8_ALIGN, PG8_SP2>(F.lds + RING_OFF, F.lds + TAB_OFF, g, S, E, F.tid, F.wave);
        SEAM(2);
    }
    if (IN(3)) { PHASE_BEGIN();
        pg8::Gemm g{F.CKV, F.Wkvb_t, M, 2048, 512}; pg8::StaticOrder S; S.init(M, 2048, F.G, (int)blockIdx.x);
        pg8::EpiKvb E{F.KVB, F.ssqc};
        pg8::gemm_phase<pg8::EpiKvb, pg8::StaticOrder, PG8_ALIGN, PG8_SP2>(F.lds + RING_OFF, F.lds + TAB_OFF, g, S, E, F.tid, F.wave);
        p3_fixup_rows(F);
        SEAM(3);
    }
    if (IN(4)) { PHASE_BEGIN();
        for (int u = F.vcu; u < 256; u += F.G) {
#ifndef ATT_SEL
#define ATT_SEL 3
#endif
            if (ATT_SEL & 1) {   const int pair = u >> 5, b = pair >> 1, kvh = pair & 1, r = u & 31, h = kvh * 4 + (r >> 3), qb = r & 7; const size_t row0 = (size_t)b * SEQ + qb * 256;
                attn::attn_unit<128, 2, 1024, 256, 256>(F.QA + row0 * 1024 + h * 128, F.KA + (size_t)b * SEQ * 256 + kvh * 128, nullptr, F.VA + (size_t)b * SEQ * 256 + kvh * 128,
                                                       F.OCAT + row0 * 2048 + h * 128, F.ssqo + row0 * 16 + h, SEQ, (char*)lds + RING_OFF, F.wave); }
            if (ATT_SEL & 2) {   const int pair = u >> 3, b = pair >> 3, h = pair & 7, qb = u & 7; const size_t row0 = (size_t)b * SEQ + qb * 256;
                attn::attn_unit<192, 1, 1536, 2048, 2048>(F.QB + row0 * 1536 + h * 192, F.KVB + (size_t)b * SEQ * 2048 + h * 256, F.KPE + (size_t)b * SEQ * 64, F.KVB + (size_t)b * SEQ * 2048 + h * 256 + 128,
                                                         F.OCAT + row0 * 2048 + 1024 + h * 128, F.ssqo + row0 * 16 + 8 + h, SEQ, (char*)lds + RING_OFF, F.wave); }
        }
        SEAM(4);
    }
    if (IN(5)) { PHASE_BEGIN();
        pg8::StaticOrder S; S.init(M, DM, F.G, (int)blockIdx.x);
        pg8::Unit u0; if (S.next(0, u0)) {
            if (F.tid < 256) { const float* sp = F.ssqo + (size_t)(u0.pm * 256 + F.tid) * 16;
                const f32x4 a0 = *(const f32x4*)sp, a1 = *(const f32x4*)(sp + 4), b0 = *(const f32x4*)(sp + 8), b1 = *(const f32x4*)(sp + 12);
                const float sa = ((a0[0] + a0[1]) + (a0[2] + a0[3])) + ((a1[0] + a1[1]) + (a1[2] + a1[3])), sb = ((b0[0] + b0[1]) + (b0[2] + b0[3])) + ((b1[0] + b1[1]) + (b1[2] + b1[3]));
                const float ra = 1.0f / sqrtf(sa * (1.0f / 1024.0f) + EPS), rb = 1.0f / sqrtf(sb * (1.0f / 1024.0f) + EPS);
                LAS float* T = (LAS float*)(F.lds + TAB_OFF); T[F.tid] = ra / rb; T[256 + F.tid] = rb; }
        }
        __syncthreads();
        pg8::Gemm g{F.OCAT, F.Wout_t, M, DM, DM};
        pg8::EpiGen<0, true, true> E{F.OPROJ, DM, F.ssqp, 32};
        pg8::gemm_phase<pg8::EpiGen<0, true, true>, pg8::StaticOrder, PG8_ALIGN, PG8_SP2>(F.lds + RING_OFF, F.lds + TAB_OFF, g, S, E, F.tid, F.wave);
        SEAM(5);
    }
    if (IN(6)) { PHASE_BEGIN(); p6_rows(F); SEAM(6); }
    if (IN(7)) { PHASE_BEGIN();
        pg8::Gemm g{F.XN, F.W1_t, M, DFF, DM}; pg8::StaticOrder S; S.init(M, DFF, F.G, (int)blockIdx.x);
        pg8::EpiGen<1, false, false> E{F.ACT, DFF, nullptr, 0};
        pg8::gemm_phase<pg8::EpiGen<1, false, false>, pg8::StaticOrder, PG8_ALIGN, PG8_SP2>(F.lds + RING_OFF, F.lds + TAB_OFF, g, S, E, F.tid, F.wave);
        SEAM(7);
    }
    if (IN(8)) { PHASE_BEGIN();
        pg8::Gemm g{F.ACT, F.W2_t, M, DM, DFF}; pg8::StaticOrder S; S.init(M, DM, F.G, (int)blockIdx.x);
        pg8::EpiGen<0, false, true> E{F.Y, DM, F.ssqy, 32};
        pg8::gemm_phase<pg8::EpiGen<0, false, true>, pg8::StaticOrder, PG8_ALIGN, PG8_SP2>(F.lds + RING_OFF, F.lds + TAB_OFF, g, S, E, F.tid, F.wave);
        SEAM(8);
    }
    if (IN(9)) { PHASE_BEGIN(); p9_rows(F); }
#undef IN
#undef BOTH
#undef SEAM
}

extern "C" void kernel_launch(void* const* d_in, const int* in_sizes, int n_in, void* d_out, int out_size, void* d_ws, size_t ws_size, hipStream_t stream) {
    static int grid = 0;
    if (grid == 0) {
        if (n_in != 18 || in_sizes[0] != M * DM || out_size != M * DM || ws_size < WS_END) { fprintf(stderr, "kernel_launch: shape/workspace mismatch (n_in %d, in0 %d, out %d, ws %zu)\n", n_in, n_in > 0 ? in_sizes[0] : -1, out_size, ws_size); grid = -1; return; }
        int dev = 0, cus = 0, per_cu = 0;
        if (hipGetDevice(&dev) != hipSuccess || hipDeviceGetAttribute(&cus, hipDeviceAttributeMultiprocessorCount, dev) != hipSuccess) { grid = -1; return; }
        if (hipFuncSetAttribute((const void*)mk_fwd, hipFuncAttributeMaxDynamicSharedMemorySize, LDS_BYTES) != hipSuccess) { fprintf(stderr, "kernel_launch: hipFuncSetAttribute failed\n"); grid = -1; return; }
        if (hipOccupancyMaxActiveBlocksPerMultiprocessor(&per_cu, (const void*)mk_fwd, NWAVES * 64, LDS_BYTES) != hipSuccess || per_cu < 1) { fprintf(stderr, "kernel_launch: occupancy query says %d blocks/CU\n", per_cu); per_cu = 1; }
        (void)hipGetLastError();
        grid = cus;
        if (grid != 256) fprintf(stderr, "kernel_launch: %d CUs (tuned for 256)\n", grid);
    }
    if (grid < 0) return;
    (void)hipMemsetAsync((char*)d_ws + WS_CTL, 0, CTL_ZERO_BYTES, stream);
    Args a{};
    for (int i = 0; i < 18; ++i) a.in[i] = (const float*)d_in[i];
    a.out = (float*)d_out; a.ws = (unsigned char*)d_ws;
    if (N_LAUNCHES == 1) {
        a.ph_lo = 0; a.ph_hi = PER_PHASE; a.li = 0;
        void* kargs[] = {&a};
        const hipError_t e = hipLaunchCooperativeKernel((const void*)mk_fwd, dim3(grid), dim3(NWAVES * 64), kargs, LDS_BYTES, stream);
        if (e != hipSuccess) fprintf(stderr, "kernel_launch: cooperative launch failed: %s (grid %d)\n", hipGetErrorString(e), grid);
    } else {
        for (int li = 0; li < PER_PHASE; ++li) {
            a.ph_lo = li; a.ph_hi = li + 1; a.li = li;
            hipLaunchKernelGGL(mk_fwd, dim3(grid), dim3(NWAVES * 64), LDS_BYTES, stream, a);
        }
        const hipError_t le = hipPeekAtLastError();
        if (le != hipSuccess) fprintf(stderr, "kernel_launch: launch failed: %s\n", hipGetErrorName(le));
    }
}
```

```cpp
#include <hip/hip_runtime.h>
#include <hip/hip_cooperative_groups.h>
#include <cstdio>
#include <cstdint>
namespace cg = cooperative_groups;

#ifndef MK_N_LAUNCHES
#define MK_N_LAUNCHES 1
#endif
#ifndef MK_CG_SEAMS
#define MK_CG_SEAMS 0x0
#endif

namespace pg8 {
#define PG8_LAS __attribute__((address_space(3)))
typedef unsigned short bf16_t;
typedef short bf16x8 __attribute__((ext_vector_type(8)));
typedef float f32x4 __attribute__((ext_vector_type(4)));
typedef unsigned u32x4 __attribute__((ext_vector_type(4)));
constexpr int BM = 256, BK = 64, HALF = 128, HTB = HALF * BK * 2, STAGE_BYTES = 8 * HTB, NXCD = 8, WGM = 8;

__host__ __device__ __forceinline__ int lds_byte(int r, int c) { const int st = (r >> 4) * 2 + (c >> 5), rr = r & 15, cc = c & 31, ob = rr * 64 + cc * 2; return st * 1024 + (ob ^ (((ob >> 9) & 1) << 5)); }
__host__ __device__ __forceinline__ void stage_rc(int b, int& R, int& C) { const int st = b / 1024, sb = b % 1024, swz = sb ^ (((sb >> 9) & 1) << 5); R = (st >> 1) * 16 + swz / 64; C = (st & 1) * 32 + (swz % 64) / 2; }
__host__ __device__ __forceinline__ int perm32(int rho) { const int n = rho >> 4, i = rho & 15; return 8 * (i >> 2) + 4 * n + (i & 3); }

struct Unit { int pm, pn; };
struct Gemm { const bf16_t* A; const bf16_t* Bt; int M, N, K; };

struct StaticOrder {
    int nM, nN, nwg, G, c;
    __host__ __device__ void init(int M, int N, int G_, int c_) { nM = M / BM; nN = N / BM; nwg = nM * nN; G = G_; c = c_; }
    __host__ __device__ bool next(int i, Unit& u) const {
        const long L = (long)i * G + c; if (L >= nwg) return false;
        int wgid = (int)L; { const int q = nwg / NXCD, r = nwg % NXCD, xcd = wgid % NXCD, off = wgid / NXCD; wgid = (xcd < r ? xcd * (q + 1) : r * (q + 1) + (xcd - r) * q) + off; }
        const int nig = WGM * nN, gid = wgid / nig, fm = gid * WGM, gsz = (nM - fm) < WGM ? (nM - fm) : WGM;
        u.pm = fm + ((wgid % nig) % gsz); u.pn = (wgid % nig) / gsz; return true;
    }
    __device__ __forceinline__ void a_ready(const Unit&) const {}
    __device__ __forceinline__ void done(const Unit&) const {}
};

__device__ __forceinline__ unsigned cvt_pk_bf16(float lo, float hi) { unsigned r; asm volatile("v_cvt_pk_bf16_f32 %0, %1, %2" : "=v"(r) : "v"(lo), "v"(hi)); return r;  }
__device__ __forceinline__ u32x4 pack8(f32x4 v0, f32x4 v1) { u32x4 w; w.x = cvt_pk_bf16(v0[0], v0[1]); w.y = cvt_pk_bf16(v0[2], v0[3]); w.z = cvt_pk_bf16(v1[0], v1[1]); w.w = cvt_pk_bf16(v1[2], v1[3]); return w; }
__device__ __forceinline__ float sq8(f32x4 a, f32x4 b) { return ((a[0] * a[0] + a[1] * a[1]) + (a[2] * a[2] + a[3] * a[3])) + ((b[0] * b[0] + b[1] * b[1]) + (b[2] * b[2] + b[3] * b[3])); }

struct EpiProj {
    static constexpr bool PERM = true, AFTER_DRAIN = false, MIDK = false;
    bf16_t *QA, *KA, *VA, *QB, *CKV, *KPE; float* ssq;
    __device__ __forceinline__ void midk(f32x4 (&)[2][2][4][2], int, int, PG8_LAS unsigned char*) const {}
    __device__ __forceinline__ void operator()(const f32x4 (&acc)[2][2][4][2], const Unit& u, int wr, int wc, int fr, int fq, PG8_LAS unsigned char*) const {
        const int pn = u.pn; bf16_t* base; int ldc, colt;
        if (pn < 4) { base = QA; ldc = 1024; colt = pn * 256; }
        else if (pn == 4) { base = KA; ldc = 256; colt = 0; }
        else if (pn == 5) { base = VA; ldc = 256; colt = 0; }
        else if (pn < 12) { base = QB; ldc = 1536; colt = (pn - 6) * 256; }
        else if (pn < 14) { base = CKV; ldc = 512; colt = (pn - 12) * 256; }
        else { base = KPE; ldc = 64; colt = 0; }
        const int row0 = u.pm * BM + wr * 64 + fr, lc0 = wc * 32 + 8 * fq;
        const bool kpe = (pn == 14), st0 = !kpe || (lc0 < 64), st1 = !kpe;
#pragma unroll
        for (int ai = 0; ai < 2; ++ai)
#pragma unroll
            for (int m = 0; m < 4; ++m) { const int row = row0 + ai * HALF + m * 16; bf16_t* rowp = base + (size_t)row * ldc + colt + lc0;
                if (st0) *(u32x4*)(rowp) = pack8(acc[ai][0][m][0], acc[ai][0][m][1]);
                if (st1) *(u32x4*)(rowp + HALF) = pack8(acc[ai][1][m][0], acc[ai][1][m][1]);
                if (pn == 12 || pn == 13) { float s = sq8(acc[ai][0][m][0], acc[ai][0][m][1]) + sq8(acc[ai][1][m][0], acc[ai][1][m][1]);
                    s += __shfl_xor(s, 16); s += __shfl_xor(s, 32);
                    if (fq == 0) ssq[(size_t)row * 8 + (pn - 12) * 4 + wc] = s; } }
    }
};
struct EpiKvb {
    static constexpr bool PERM = true, AFTER_DRAIN = false, MIDK = false;
    bf16_t* O; const float* ssq;
    __device__ __forceinline__ void midk(f32x4 (&)[2][2][4][2], int, int, PG8_LAS unsigned char*) const {}
    __device__ __forceinline__ void operator()(const f32x4 (&acc)[2][2][4][2], const Unit& u, int wr, int wc, int fr, int fq, PG8_LAS unsigned char*) const {
        const int row0 = u.pm * BM + wr * 64 + fr, col0 = u.pn * BM + wc * 32 + 8 * fq;
#pragma unroll
        for (int ai = 0; ai < 2; ++ai)
#pragma unroll
            for (int m = 0; m < 4; ++m) { const int row = row0 + ai * HALF + m * 16;
                const f32x4 a = *(const f32x4*)(ssq + (size_t)row * 8), b = *(const f32x4*)(ssq + (size_t)row * 8 + 4);
                const float inv = 1.0f / sqrtf((((a[0] + a[1]) + (a[2] + a[3])) + ((b[0] + b[1]) + (b[2] + b[3]))) * (1.0f / 512.0f) + 1e-6f);
                bf16_t* rowp = O + (size_t)row * 2048 + col0;
                *(u32x4*)(rowp) = pack8(acc[ai][0][m][0] * inv, acc[ai][0][m][1] * inv);
                *(u32x4*)(rowp + HALF) = pack8(acc[ai][1][m][0] * inv, acc[ai][1][m][1] * inv); }
    }
};
template <int ACT  , bool ROWSCALE, bool SSQ> struct EpiGen {
    static constexpr bool PERM = true, AFTER_DRAIN = false, MIDK = ROWSCALE;
    bf16_t* O; int ldc; float* ssq;
    int nssq;
    __device__ __forceinline__ void midk(f32x4 (&acc)[2][2][4][2], int wr, int fr, PG8_LAS unsigned char* tab) const {
        if constexpr (ROWSCALE) {
            const PG8_LAS float* T = (const PG8_LAS float*)tab;
#pragma unroll
            for (int ai = 0; ai < 2; ++ai)
#pragma unroll
                for (int m = 0; m < 4; ++m) { const float r = T[ai * HALF + wr * 64 + m * 16 + fr];
#pragma unroll
                    for (int bj = 0; bj < 2; ++bj)
#pragma unroll
                        for (int n = 0; n < 2; ++n) acc[ai][bj][m][n] = acc[ai][bj][m][n] * r; }
        }
    }
    __device__ __forceinline__ void operator()(const f32x4 (&acc)[2][2][4][2], const Unit& u, int wr, int wc, int fr, int fq, PG8_LAS unsigned char* tab) const {
        const int row0 = u.pm * BM + wr * 64 + fr, col0 = u.pn * BM + wc * 32 + 8 * fq;
        const PG8_LAS float* T = (const PG8_LAS float*)tab;
#pragma unroll
        for (int ai = 0; ai < 2; ++ai)
#pragma unroll
            for (int m = 0; m < 4; ++m) { const int row = row0 + ai * HALF + m * 16;
                float sc = 1.0f; if constexpr (ROWSCALE) sc = T[256 + ai * HALF + wr * 64 + m * 16 + fr];
                f32x4 v[2][2];
#pragma unroll
                for (int bj = 0; bj < 2; ++bj)
#pragma unroll
                    for (int n = 0; n < 2; ++n) { f32x4 x = acc[ai][bj][m][n];
                        if constexpr (ROWSCALE) x = x * sc;
                        if constexpr (ACT == 1) { x[0] = fmaxf(x[0], 0.f); x[1] = fmaxf(x[1], 0.f); x[2] = fmaxf(x[2], 0.f); x[3] = fmaxf(x[3], 0.f); x = x * x; }
                        v[bj][n] = x; }
                bf16_t* rowp = O + (size_t)row * ldc + col0;
                *(u32x4*)(rowp) = pack8(v[0][0], v[0][1]);
                *(u32x4*)(rowp + HALF) = pack8(v[1][0], v[1][1]);
                if constexpr (SSQ) { float s = sq8(v[0][0], v[0][1]) + sq8(v[1][0], v[1][1]);
                    s += __shfl_xor(s, 16); s += __shfl_xor(s, 32);
                    if (fq == 0) ssq[(size_t)row * nssq + u.pn * 4 + wc] = s; } }
    }
};

template <class Epi, class Sched, bool ALIGN_EPI = false, bool SP2 = false>
__device__ __forceinline__ void gemm_phase(PG8_LAS unsigned char* lds, PG8_LAS unsigned char* tab, const Gemm g, const Sched& S, const Epi& E, const int tid, const int wid  ) {
    const int lane = tid & 63, wr = wid >> 2, wc = wid & 3, fr = lane & 15, fq = lane >> 4;
    const int K = g.K, nt = K / BK;
    unsigned voffA[2], voffB[2];
#pragma unroll
    for (int i = 0; i < 2; ++i) { int R, C; stage_rc(tid * 16 + i * 8192, R, C); const int Rb = Epi::PERM ? ((R & ~31) + perm32(R & 31)) : R;
        voffA[i] = (unsigned)(R * K + C) * 2u; voffB[i] = (unsigned)(Rb * K + C) * 2u; }
    const size_t kstep = (size_t)(BK * 2);
    const size_t hstep = (size_t)HALF * K * 2;
    const size_t tstep = 2 * hstep;
    const unsigned ldsw = (unsigned)wid * 1024u;
    const int aoff = lds_byte(wr * 64 + fr, fq * 8), boff = lds_byte(wc * 32 + fr, fq * 8);
#define PG8_SA(b, h) (((b) * 2 + (h)) * HTB)
#define PG8_SB(b, h) ((4 + (b) * 2 + (h)) * HTB)
#define PG8_STAGE(bufoff, gbase, voff) do { _Pragma("unroll") for (int _i = 0; _i < 2; ++_i) \
        __builtin_amdgcn_global_load_lds((const unsigned*)((const char*)(gbase) + (voff)[_i]), (PG8_LAS unsigned*)(lds + (bufoff) + ldsw + _i * 8192), 16, 0, 0); } while (0)
#define PG8_LDA(dst, b, h) do { _Pragma("unroll") for (int m = 0; m < 4; ++m) _Pragma("unroll") for (int k = 0; k < 2; ++k) dst[m][k] = *(const PG8_LAS bf16x8*)(lds + PG8_SA(b, h) + aoff + m * 2048 + k * 1024); } while (0)
#define PG8_LDB(dst, b, h) do { _Pragma("unroll") for (int n = 0; n < 2; ++n) _Pragma("unroll") for (int k = 0; k < 2; ++k) dst[n][k] = *(const PG8_LAS bf16x8*)(lds + PG8_SB(b, h) + boff + n * 2048 + k * 1024); } while (0)
#define PG8_MMA(ai, bj, At, Bt) do { __builtin_amdgcn_s_setprio(1); _Pragma("unroll") for (int m = 0; m < 4; ++m) _Pragma("unroll") for (int n = 0; n < 2; ++n) _Pragma("unroll") for (int k = 0; k < 2; ++k) \
        acc[ai][bj][m][n] = __builtin_amdgcn_mfma_f32_16x16x32_bf16(Bt[n][k], At[m][k], acc[ai][bj][m][n], 0, 0, 0); __builtin_amdgcn_s_setprio(0); } while (0)
#define PG8_WAIT_V(n) asm volatile("s_waitcnt vmcnt(" #n ")" ::: "memory")
#define PG8_WAIT_L(n) asm volatile("s_waitcnt lgkmcnt(" #n ")" ::: "memory")
#define PG8_BAR __builtin_amdgcn_s_barrier()
#define PG8_SCHED __builtin_amdgcn_sched_barrier(0)
    Unit cur, nxt; int ui = 0;
    if (!S.next(0, cur)) return;
    f32x4 acc[2][2][4][2];
#pragma unroll
    for (int a = 0; a < 2; ++a)
#pragma unroll
        for (int b = 0; b < 2; ++b)
#pragma unroll
            for (int m = 0; m < 4; ++m)
#pragma unroll
                for (int n = 0; n < 2; ++n) acc[a][b][m][n] = (f32x4){0.f, 0.f, 0.f, 0.f};
    bf16x8 At[4][2], B0[2][2], B1[2][2];
    const char* cA = (const char*)g.A + (size_t)cur.pm * tstep; const char* cB = (const char*)g.Bt + (size_t)cur.pn * tstep;
    S.a_ready(cur);
    if constexpr (SP2) {
        PG8_STAGE(PG8_SB(0, 0), cB, voffB); PG8_STAGE(PG8_SB(0, 1), cB + hstep, voffB); PG8_STAGE(PG8_SA(0, 0), cA, voffA); PG8_STAGE(PG8_SA(0, 1), cA + hstep, voffA);
        if (wr == 1) PG8_BAR;
        PG8_WAIT_V(2); PG8_BAR;
        PG8_STAGE(PG8_SB(1, 0), cB + kstep, voffB); PG8_STAGE(PG8_SA(1, 0), cA + kstep, voffA); PG8_STAGE(PG8_SB(1, 1), cB + hstep + kstep, voffB);
        PG8_WAIT_V(6); PG8_BAR;
    } else {
        PG8_STAGE(PG8_SB(0, 0), cB, voffB); PG8_STAGE(PG8_SA(0, 0), cA, voffA); PG8_STAGE(PG8_SB(0, 1), cB + hstep, voffB); PG8_STAGE(PG8_SA(0, 1), cA + hstep, voffA);
        if (wr == 1) PG8_BAR;
        PG8_WAIT_V(4); PG8_BAR;
        PG8_STAGE(PG8_SB(1, 0), cB + kstep, voffB); PG8_STAGE(PG8_SA(1, 0), cA + kstep, voffA); PG8_STAGE(PG8_SB(1, 1), cB + hstep + kstep, voffB);
        PG8_WAIT_V(6); PG8_BAR;
    }
    for (;;) {
        const bool has_next = S.next(ui + 1, nxt);
        const char* nA = has_next ? (const char*)g.A + (size_t)nxt.pm * tstep : cA; const char* nB = has_next ? (const char*)g.Bt + (size_t)nxt.pn * tstep : cB;
        for (int t = 0; t < nt; t += 2) {
            if constexpr (Epi::MIDK) { if (t == (nt >> 1)) E.midk(acc, wr, fr, tab); }
            const bool last = (t == nt - 2);
            const char* a1 = cA + (size_t)(t + 1) * kstep;
            const char* a2 = last ? nA : cA + (size_t)(t + 2) * kstep; const char* b2 = last ? nB : cB + (size_t)(t + 2) * kstep;
            const char* a3 = a2 + kstep; const char* b3 = b2 + kstep;
            if (last && has_next) S.a_ready(nxt);
            if constexpr (SP2) {
            PG8_LDB(B0, 0, 0); PG8_LDB(B1, 0, 1); PG8_SCHED; PG8_LDA(At, 0, 0); PG8_STAGE(PG8_SA(1, 1), a1 + hstep, voffA);
            PG8_WAIT_V(8); PG8_WAIT_L(0); PG8_BAR; PG8_MMA(0, 0, At, B0); PG8_MMA(0, 1, At, B1); PG8_BAR; PG8_SCHED;
            PG8_LDA(At, 0, 1); PG8_STAGE(PG8_SB(0, 0), b2, voffB); PG8_STAGE(PG8_SB(0, 1), b2 + hstep, voffB); PG8_STAGE(PG8_SA(0, 0), a2, voffA);
            PG8_WAIT_V(8); PG8_WAIT_L(0); PG8_BAR; PG8_MMA(1, 0, At, B0); PG8_MMA(1, 1, At, B1); PG8_BAR; PG8_SCHED;
            PG8_LDB(B0, 1, 0); PG8_LDB(B1, 1, 1); PG8_SCHED; PG8_LDA(At, 1, 0); PG8_STAGE(PG8_SA(0, 1), a2 + hstep, voffA);
            PG8_WAIT_V(8); PG8_WAIT_L(0); PG8_BAR; PG8_MMA(0, 0, At, B0); PG8_MMA(0, 1, At, B1); PG8_BAR; PG8_SCHED;
            PG8_LDA(At, 1, 1); PG8_STAGE(PG8_SB(1, 0), b3, voffB); PG8_STAGE(PG8_SB(1, 1), b3 + hstep, voffB); PG8_STAGE(PG8_SA(1, 0), a3, voffA);
            PG8_WAIT_V(8); PG8_WAIT_L(0); PG8_BAR; PG8_MMA(1, 0, At, B0); PG8_MMA(1, 1, At, B1); PG8_BAR; PG8_SCHED;
            } else {
            PG8_LDB(B0, 0, 0); PG8_SCHED; PG8_LDA(At, 0, 0); PG8_STAGE(PG8_SA(1, 1), a1 + hstep, voffA);
            PG8_WAIT_L(8); PG8_BAR; PG8_WAIT_L(0); PG8_MMA(0, 0, At, B0); PG8_BAR; PG8_SCHED;
            PG8_LDB(B1, 0, 1); PG8_STAGE(PG8_SB(0, 0), b2, voffB);
            PG8_BAR; PG8_WAIT_L(0); PG8_MMA(0, 1, At, B1); PG8_BAR;
            PG8_LDA(At, 0, 1); PG8_STAGE(PG8_SA(0, 0), a2, voffA);
            PG8_BAR; PG8_WAIT_L(0); PG8_MMA(1, 0, At, B0); PG8_BAR; PG8_SCHED;
            PG8_STAGE(PG8_SB(0, 1), b2 + hstep, voffB);
            PG8_WAIT_V(6); PG8_BAR; PG8_MMA(1, 1, At, B1); PG8_BAR;
            PG8_LDB(B0, 1, 0); PG8_SCHED; PG8_LDA(At, 1, 0); PG8_STAGE(PG8_SA(0, 1), a2 + hstep, voffA);
            PG8_WAIT_L(8); PG8_BAR; PG8_WAIT_L(0); PG8_MMA(0, 0, At, B0); PG8_BAR; PG8_SCHED;
            PG8_LDB(B1, 1, 1); PG8_STAGE(PG8_SB(1, 0), b3, voffB);
            PG8_BAR; PG8_WAIT_L(0); PG8_MMA(0, 1, At, B1); PG8_BAR;
            PG8_LDA(At, 1, 1); PG8_STAGE(PG8_SA(1, 0), a3, voffA);
            PG8_BAR; PG8_WAIT_L(0); PG8_MMA(1, 0, At, B0); PG8_BAR; PG8_SCHED;
            PG8_STAGE(PG8_SB(1, 1), b3 + hstep, voffB);
            PG8_WAIT_V(6); PG8_BAR; PG8_MMA(1, 1, At, B1); PG8_BAR;
            }
        }
        if constexpr (ALIGN_EPI) { if (wr == 0) PG8_BAR; }
        E(acc, cur, wr, wc, fr, fq, tab); S.done(cur);
        if (!has_next) break;
#pragma unroll
        for (int a = 0; a < 2; ++a)
#pragma unroll
            for (int b = 0; b < 2; ++b)
#pragma unroll
                for (int m = 0; m < 4; ++m)
#pragma unroll
                    for (int n = 0; n < 2; ++n) acc[a][b][m][n] = (f32x4){0.f, 0.f, 0.f, 0.f};
        cur = nxt; cA = nA; cB = nB; ++ui;
        if constexpr (ALIGN_EPI) { if (wr == 1) PG8_BAR; }
    }
    PG8_WAIT_V(0);
    if constexpr (!ALIGN_EPI) { if (wr == 0) PG8_BAR; }
    PG8_BAR;
#undef PG8_SA
#undef PG8_SB
#undef PG8_STAGE
#undef PG8_LDA
#undef PG8_LDB
#undef PG8_MMA
#undef PG8_WAIT_V
#undef PG8_WAIT_L
#undef PG8_BAR
#undef PG8_SCHED
}
}

#define PG8_SP2 true
#define PG8_ALIGN true

namespace attn {
typedef unsigned short bf16_t;
using bf16x8 = __attribute__((ext_vector_type(8))) short;
using s16x4  = __attribute__((ext_vector_type(4))) short;
using f32x16 = __attribute__((ext_vector_type(16))) float;
using u32x4  = __attribute__((ext_vector_type(4))) unsigned;
constexpr int NW = 8, QBLK = 32, KVBLK = 64;
constexpr int SHM_V = KVBLK * 128 * 2, SHM_K = KVBLK * 128 * 2, SHM_KP = KVBLK * 64 * 2;
constexpr int OFF_V = 0, OFF_K = 2 * SHM_V, OFF_WS = OFF_K + 2 * SHM_K, OFF_KP = OFF_WS + NW * 64 * 4, LDS_BYTES = OFF_KP + 2 * SHM_KP;
constexpr float THR = 8.f;
#define KSWZ(row, colB) ((row) * 256 + ((colB) ^ (((row) & 7) << 4)))
#define KPSWZ(row, colB) ((row) * 128 + ((colB) ^ (((row) & 7) << 4)))
#define SBAR() __builtin_amdgcn_sched_barrier(0)
__device__ __forceinline__ int crow(int r, int hi) { return (r & 3) + 8 * (r >> 2) + 4 * hi; }
__device__ __forceinline__ unsigned cvtpk(float lo, float hi) { unsigned r; asm volatile("v_cvt_pk_bf16_f32 %0, %1, %2" : "=v"(r) : "v"(lo), "v"(hi)); return r; }
__device__ __forceinline__ bf16x8 ld8(const bf16_t* p) { return *reinterpret_cast<const bf16x8*>(p); }

template <int DQK> struct Cst { static constexpr float SCALE = (DQK == 128) ? 0.088388347648318440f : 0.072168783648703220f; };

template <int DQK>
__device__ __forceinline__ void partialSM(f32x16& p0, f32x16& p1, float& m_reg, float& mn, float& alpha) {
  constexpr float SCALE = Cst<DQK>::SCALE, C = SCALE * 1.4426950408889634f;
  float pmax = p0[0];
#pragma unroll
  for (int r = 1; r < 16; ++r) pmax = fmaxf(pmax, p0[r]);
#pragma unroll
  for (int r = 0; r < 16; ++r) pmax = fmaxf(pmax, p1[r]);
  { auto rr = __builtin_amdgcn_permlane32_swap(__float_as_uint(pmax), __float_as_uint(pmax), false, false);
    pmax = fmaxf(__uint_as_float(rr[0]), __uint_as_float(rr[1])); }
  if (__builtin_expect(__all(pmax - m_reg <= THR / SCALE), 1)) { mn = m_reg; alpha = 1.f; }
  else { mn = fmaxf(m_reg, pmax); alpha = __builtin_amdgcn_exp2f((m_reg - mn) * C); m_reg = mn; }
  float mnC = -mn * C;
#pragma unroll
  for (int r = 0; r < 16; ++r) p0[r] = fmaf(p0[r], C, mnC);
#pragma unroll
  for (int r = 0; r < 16; ++r) p1[r] = fmaf(p1[r], C, mnC);
#pragma unroll
  for (int r = 0; r < 16; ++r) p0[r] = __builtin_amdgcn_exp2f(p0[r]);
}
__device__ __forceinline__ void finishSM(f32x16& p0, f32x16& p1, float alpha, float& l_reg, bf16x8& pa0, bf16x8& pa1, bf16x8& pa2, bf16x8& pa3) {
#pragma unroll
  for (int r = 0; r < 16; ++r) p1[r] = __builtin_amdgcn_exp2f(p1[r]);
  float ps = 0;
#pragma unroll
  for (int r = 0; r < 16; ++r) ps += p0[r];
#pragma unroll
  for (int r = 0; r < 16; ++r) ps += p1[r];
  { auto rr = __builtin_amdgcn_permlane32_swap(__float_as_uint(ps), __float_as_uint(ps), false, false);
    ps = __uint_as_float(rr[0]) + __uint_as_float(rr[1]); }
  l_reg = l_reg * alpha + ps;
#define PK4(P, BASE, OUT) do { unsigned a0 = cvtpk(P[BASE + 0], P[BASE + 1]), a1 = cvtpk(P[BASE + 2], P[BASE + 3]);   \
    unsigned b0 = cvtpk(P[BASE + 4], P[BASE + 5]), b1 = cvtpk(P[BASE + 6], P[BASE + 7]);                              \
    auto r0 = __builtin_amdgcn_permlane32_swap(a0, b0, false, false); auto r1 = __builtin_amdgcn_permlane32_swap(a1, b1, false, false); \
    u32x4 w = {r0[0], r1[0], r0[1], r1[1]}; OUT = *reinterpret_cast<bf16x8*>(&w); } while (0)
  PK4(p0, 0, pa0); PK4(p0, 8, pa1); PK4(p1, 0, pa2); PK4(p1, 8, pa3);
#undef PK4
}
template <int DQK>
__device__ __forceinline__ void qkt(f32x16& p0, f32x16& p1, const char* Ks, const char* Kps, const bf16x8* qr, int r32, int hi) {
  p0 = f32x16{}; p1 = f32x16{};
#pragma unroll
  for (int d0 = 0; d0 < 8; ++d0) { int cb = (d0 * 16 + hi * 8) * 2;
    bf16x8 b0 = *reinterpret_cast<const bf16x8*>(Ks + KSWZ(r32, cb));
    bf16x8 b1 = *reinterpret_cast<const bf16x8*>(Ks + KSWZ(32 + r32, cb));
    p0 = __builtin_amdgcn_mfma_f32_32x32x16_bf16(b0, qr[d0], p0, 0, 0, 0);
    p1 = __builtin_amdgcn_mfma_f32_32x32x16_bf16(b1, qr[d0], p1, 0, 0, 0); }
  if constexpr (DQK == 192) {
#pragma unroll
    for (int d0 = 0; d0 < 4; ++d0) { int cb = (d0 * 16 + hi * 8) * 2;
      bf16x8 b0 = *reinterpret_cast<const bf16x8*>(Kps + KPSWZ(r32, cb));
      bf16x8 b1 = *reinterpret_cast<const bf16x8*>(Kps + KPSWZ(32 + r32, cb));
      p0 = __builtin_amdgcn_mfma_f32_32x32x16_bf16(b0, qr[8 + d0], p0, 0, 0, 0);
      p1 = __builtin_amdgcn_mfma_f32_32x32x16_bf16(b1, qr[8 + d0], p1, 0, 0, 0); }
  }
}
__device__ __forceinline__ int v_st(int k, int c) { const int kk = (k & ~0xC) | ((k & 4) << 1) | ((k & 8) >> 1); return ((kk >> 3) * 4 + (c >> 5)) * 512 + ((kk & 7) * 32 + (c & 31)) * 2; }
__device__ __forceinline__ int v_rd_base(int lane) { return ((lane & 3) << 3) | (((lane >> 2) & 3) << 6) | (((lane >> 4) & 1) << 5) | (((lane >> 5) & 1) << 8); }
constexpr int v_rd_off(int d0, int ks, int half) { return d0 * 512 + ks * 4096 + half * 2048; }
template <int OFF> __device__ __forceinline__ s16x4 tr_read(int vb) {
  s16x4 r; asm volatile("ds_read_b64_tr_b16 %0, %1 offset:%2" : "=&v"(r) : "v"(vb), "i"(OFF) : "memory"); return r;
}
template <int D0> __device__ __forceinline__ void pv_one(f32x16& od, int vb, bf16x8 pa0, bf16x8 pa1, bf16x8 pa2, bf16x8 pa3) {
  const s16x4 l0 = tr_read<v_rd_off(D0, 0, 0)>(vb), h0 = tr_read<v_rd_off(D0, 0, 1)>(vb), l1 = tr_read<v_rd_off(D0, 1, 0)>(vb), h1 = tr_read<v_rd_off(D0, 1, 1)>(vb);
  const s16x4 l2 = tr_read<v_rd_off(D0, 2, 0)>(vb), h2 = tr_read<v_rd_off(D0, 2, 1)>(vb), l3 = tr_read<v_rd_off(D0, 3, 0)>(vb), h3 = tr_read<v_rd_off(D0, 3, 1)>(vb);
  asm volatile("s_waitcnt lgkmcnt(0)" ::: "memory"); SBAR();
#define PK(L, H) (bf16x8){L[0], L[1], L[2], L[3], H[0], H[1], H[2], H[3]}
  od = __builtin_amdgcn_mfma_f32_32x32x16_bf16(pa0, PK(l0, h0), od, 0, 0, 0);
  od = __builtin_amdgcn_mfma_f32_32x32x16_bf16(pa1, PK(l1, h1), od, 0, 0, 0);
  od = __builtin_amdgcn_mfma_f32_32x32x16_bf16(pa2, PK(l2, h2), od, 0, 0, 0);
  od = __builtin_amdgcn_mfma_f32_32x32x16_bf16(pa3, PK(l3, h3), od, 0, 0, 0);
#undef PK
}
__device__ __forceinline__ void pv_d0(f32x16* o, int vb, bf16x8 pa0, bf16x8 pa1, bf16x8 pa2, bf16x8 pa3) {
  pv_one<0>(o[0], vb, pa0, pa1, pa2, pa3); pv_one<1>(o[1], vb, pa0, pa1, pa2, pa3); pv_one<2>(o[2], vb, pa0, pa1, pa2, pa3); pv_one<3>(o[3], vb, pa0, pa1, pa2, pa3);
}

template <int DQK, int SDEPTH, int LDQ, int LDKN, int LDV>
__device__ __forceinline__ void attn_unit(const bf16_t* __restrict__ Qb, const bf16_t* __restrict__ Kn, const bf16_t* __restrict__ Kp, const bf16_t* __restrict__ Vh,
                                          bf16_t* __restrict__ Ob, float* __restrict__ ssq, int seq, char* lds, int wid_s) {
  constexpr int NQ = DQK / 16;
  unsigned z_s = 0u; asm volatile("" : "+v"(z_s));
  const int lane = __builtin_amdgcn_mbcnt_hi(~0u, __builtin_amdgcn_mbcnt_lo(~0u, z_s)), wid = wid_s, tid = wid_s * 64 + lane, r32 = lane & 31, hi = lane >> 5;
  char* V_lds = lds + OFF_V; char* K_lds = lds + OFF_K; char* Kp_lds = lds + OFF_KP;
  float* ws = (float*)(lds + OFF_WS) + wid * 64; float* li_l = ws; float* al_l = ws + 32;
  float m_reg = -1e30f, l_reg = 0; f32x16 o[4] = {}; bf16x8 qr[NQ];
  const bf16_t* Qw = Qb + (long)(wid * QBLK + r32) * LDQ + hi * 8;
#pragma unroll
  for (int d0 = 0; d0 < NQ; ++d0) qr[d0] = ld8(Qw + d0 * 16);
  const int sr = tid >> 4, sc = (tid & 15) * 8, vst0 = v_st(sr, sc), vst1 = v_st(32 + sr, sc);
  const int pr = tid >> 3, pc = (tid & 7) * 8;
  const int vb0 = (int)(uintptr_t)V_lds + v_rd_base(lane);
  struct { bf16x8 vs0, vs1, ks0, ks1, kp; } sr_[SDEPTH];
#define SLOAD(i, k0) do { sr_[i].vs0 = ld8(&Vh[(long)((k0) + sr) * LDV + sc]); sr_[i].vs1 = ld8(&Vh[(long)((k0) + 32 + sr) * LDV + sc]); \
    sr_[i].ks0 = ld8(&Kn[(long)((k0) + sr) * LDKN + sc]); sr_[i].ks1 = ld8(&Kn[(long)((k0) + 32 + sr) * LDKN + sc]); \
    if constexpr (DQK == 192) sr_[i].kp = ld8(&Kp[(long)((k0) + pr) * 64 + pc]); } while (0)
#define SWRITE(b, i) do { *(bf16x8*)(V_lds + (b) * SHM_V + vst0) = sr_[i].vs0;          \
    *(bf16x8*)(V_lds + (b) * SHM_V + vst1) = sr_[i].vs1; int kc = sc * 2;               \
    *(bf16x8*)(K_lds + (b) * SHM_K + KSWZ(sr, kc)) = sr_[i].ks0;                       \
    *(bf16x8*)(K_lds + (b) * SHM_K + KSWZ(32 + sr, kc)) = sr_[i].ks1;                  \
    if constexpr (DQK == 192) *(bf16x8*)(Kp_lds + (b) * SHM_KP + KPSWZ(pr, pc * 2)) = sr_[i].kp; } while (0)
#define SWAIT() do { if constexpr (SDEPTH == 2) { if constexpr (DQK == 192) asm volatile("s_waitcnt vmcnt(5)" ::: "memory"); else asm volatile("s_waitcnt vmcnt(4)" ::: "memory"); } \
    else asm volatile("s_waitcnt vmcnt(0)" ::: "memory"); } while (0)
#define RESC(a) do { if (__any((a) < 1.f)) { if (hi == 0) al_l[r32] = (a); asm volatile("s_waitcnt lgkmcnt(0)" ::: "memory"); \
    _Pragma("unroll") for (int d = 0; d < 4; ++d) _Pragma("unroll") for (int r = 0; r < 16; ++r) o[d][r] *= al_l[crow(r, hi)]; } } while (0)
  f32x16 pA0, pA1, pB0, pB1; float mnA, mnB, alA, alB; bf16x8 pa0, pa1, pa2, pa3; const int NT = seq / KVBLK;
  constexpr int SE = 0, SO = SDEPTH - 1;
  SLOAD(SE, 0); asm volatile("s_waitcnt vmcnt(0)" ::: "memory"); SWRITE(0, SE); __syncthreads();
  qkt<DQK>(pA0, pA1, K_lds, Kp_lds, qr, r32, hi); partialSM<DQK>(pA0, pA1, m_reg, mnA, alA);
  SLOAD(SO, KVBLK); if constexpr (SDEPTH == 2) { if (2 < NT) SLOAD(SE, 2 * KVBLK); }
  SWAIT(); SWRITE(1, SO); __syncthreads();
  for (int j = 1; j + 1 < NT; j += 2) {
    SBAR(); qkt<DQK>(pB0, pB1, K_lds + SHM_K, Kp_lds + SHM_KP, qr, r32, hi);
    finishSM(pA0, pA1, alA, l_reg, pa0, pa1, pa2, pa3); SBAR();
    SLOAD(SO, (j + SDEPTH) * KVBLK); SBAR();
    pv_d0(o, vb0, pa0, pa1, pa2, pa3); partialSM<DQK>(pB0, pB1, m_reg, mnB, alB);
    __syncthreads(); SWAIT(); SWRITE(0, SE);
    RESC(alB); __syncthreads();
    SBAR(); qkt<DQK>(pA0, pA1, K_lds, Kp_lds, qr, r32, hi);
    finishSM(pB0, pB1, alB, l_reg, pa0, pa1, pa2, pa3); SBAR();
    if (SDEPTH == 1 || j + 3 < NT) SLOAD(SE, (j + 1 + SDEPTH) * KVBLK); SBAR();
    pv_d0(o, vb0 + (int)SHM_V, pa0, pa1, pa2, pa3); partialSM<DQK>(pA0, pA1, m_reg, mnA, alA);
    __syncthreads(); SWAIT(); SWRITE(1, SO);
    RESC(alA); __syncthreads();
  }
  SBAR(); qkt<DQK>(pB0, pB1, K_lds + SHM_K, Kp_lds + SHM_KP, qr, r32, hi);
  finishSM(pA0, pA1, alA, l_reg, pa0, pa1, pa2, pa3); SBAR();
  pv_d0(o, vb0, pa0, pa1, pa2, pa3); partialSM<DQK>(pB0, pB1, m_reg, mnB, alB);
  __syncthreads(); RESC(alB);
  finishSM(pB0, pB1, alB, l_reg, pa0, pa1, pa2, pa3); SBAR();
  pv_d0(o, vb0 + (int)SHM_V, pa0, pa1, pa2, pa3);
  unsigned z_e = 0u; asm volatile("" : "+v"(z_e));
  const int lane_e_ = __builtin_amdgcn_mbcnt_hi(~0u, __builtin_amdgcn_mbcnt_lo(~0u, z_e));
  const int lane_e = lane_e_, r32e = lane_e & 31, hie = lane_e >> 5;
  float* li_e = (float*)(lds + OFF_WS) + wid_s * 64;
  if (hie == 0) li_e[r32e] = l_reg; asm volatile("s_waitcnt lgkmcnt(0)" ::: "memory");
  __syncthreads();
  bf16_t* stg = (bf16_t*)(lds + wid_s * 8192);
#pragma unroll
  for (int r = 0; r < 16; ++r) { const int orow = crow(r, hie); const float rl = __builtin_amdgcn_rcpf(li_e[orow]);
#pragma unroll
    for (int d0 = 0; d0 < 4; ++d0) { const unsigned w = cvtpk(o[d0][r] * rl, 0.f); stg[orow * 128 + d0 * 32 + r32e] = (bf16_t)(w & 0xffffu); } }
  asm volatile("s_waitcnt lgkmcnt(0)" ::: "memory");
  bf16_t* Ow = Ob + (long)(wid_s * QBLK) * 2048; float* sw = ssq + (long)(wid_s * QBLK) * 16;
#pragma unroll
  for (int i = 0; i < 8; ++i) { const int row = i * 4 + (lane_e >> 4), ch = lane_e & 15;
    const u32x4 v = *(const u32x4*)(stg + row * 128 + ch * 8);
    float s = 0.f;
#pragma unroll
    for (int e = 0; e < 4; ++e) { const float a = __uint_as_float(v[e] << 16), b = __uint_as_float(v[e] & 0xffff0000u); s += a * a + b * b; }
    s += __int_as_float(__builtin_amdgcn_ds_bpermute((lane_e ^ 1) << 2, __float_as_int(s))); s += __int_as_float(__builtin_amdgcn_ds_bpermute((lane_e ^ 2) << 2, __float_as_int(s)));
    s += __int_as_float(__builtin_amdgcn_ds_bpermute((lane_e ^ 4) << 2, __float_as_int(s))); s += __int_as_float(__builtin_amdgcn_ds_bpermute((lane_e ^ 8) << 2, __float_as_int(s)));
    *(u32x4*)(Ow + (long)row * 2048 + ch * 8) = v;
    if (ch == 0) sw[row * 16] = s; }
  __syncthreads();
#undef SLOAD
#undef SWRITE
#undef SWAIT
#undef RESC
}
#undef KSWZ
#undef KPSWZ
#undef SBAR
}

constexpr int NWAVES = 8;
constexpr int N_LAUNCHES = MK_N_LAUNCHES;
constexpr int PER_PHASE = 10;
constexpr int BATCH = 4, SEQ = 2048, DM = 2048, M = BATCH * SEQ;
constexpr int W_IN = 3648, W_INP = 3840, DFF = 8192, NMODW = 6 * DM;
constexpr float EPS = 1e-6f;

constexpr size_t MiB = 1u << 20;
constexpr size_t WS_CTL = 0, CTL_ZERO_BYTES = 64 * 1024;
constexpr size_t WS_MOD = 1 * MiB;
constexpr size_t WS_TAB = WS_MOD + 256 * 1024;
constexpr size_t WS_SSQC = 2 * MiB;
constexpr size_t WS_SSQO = WS_SSQC + 256 * 1024;
constexpr size_t WS_SSQP = WS_SSQO + 512 * 1024;
constexpr size_t WS_SSQY = WS_SSQP + 1024 * 1024;
constexpr size_t WS_WIN = 6 * MiB, WS_WKVB = 21 * MiB, WS_WOUT = 23 * MiB, WS_W1 = 31 * MiB, WS_W2 = 63 * MiB;
constexpr size_t WS_XN = 95 * MiB;
constexpr size_t WS_QA = 127 * MiB, WS_KA = 143 * MiB, WS_VA = 147 * MiB, WS_QB = 151 * MiB, WS_CKV = 175 * MiB, WS_KPE = 183 * MiB;
constexpr size_t WS_KVB = 184 * MiB, WS_OCAT = 216 * MiB, WS_OPROJ = 248 * MiB;
constexpr size_t WS_ACT = 127 * MiB;
constexpr size_t WS_Y = 280 * MiB, WS_END = 312 * MiB;
static_assert(WS_SSQY + 1024 * 1024 <= WS_WIN && WS_ACT + (size_t)M * DFF * 2 <= WS_Y, "d_ws map");
constexpr int CW_BAR = 1024;

constexpr int RING_OFF = 0, RING_BYTES = 131072;
constexpr int TAB_OFF = RING_BYTES;
constexpr int LDSCTL_OFF = TAB_OFF + 2048, MISC_OFF = LDSCTL_OFF + 320;
constexpr int LDS_BYTES = 147456;
static_assert(MISC_OFF + 128 <= LDS_BYTES && attn::LDS_BYTES <= RING_BYTES, "LDS map");

#define GAS __attribute__((address_space(1)))
#define LAS __attribute__((address_space(3)))
typedef unsigned short bf16;
typedef unsigned v4u __attribute__((ext_vector_type(4)));
typedef unsigned v2u __attribute__((ext_vector_type(2)));
typedef float f32x4 __attribute__((ext_vector_type(4)));
typedef GAS unsigned gu32;
#define RLX_AGENT __ATOMIC_RELAXED, __HIP_MEMORY_SCOPE_AGENT
#define LDS_WAIT() asm volatile("s_waitcnt lgkmcnt(0)" ::: "memory")
__device__ __forceinline__ unsigned f2bf(float f) { unsigned u = __builtin_bit_cast(unsigned, f); return (u + 0x7fffu + ((u >> 16) & 1u)) >> 16; }
__device__ __forceinline__ unsigned pk2(float lo, float hi) { return f2bf(lo) | (f2bf(hi) << 16); }
__device__ __forceinline__ float bflo(unsigned w) { return __uint_as_float(w << 16); }
__device__ __forceinline__ float bfhi(unsigned w) { return __uint_as_float(w & 0xffff0000u); }

#define XB_TMO      128
#define XB_XCNT(j)  (256  + 64 * (j))
#define XB_XSUB(j)  (1280 + 64 * (j))
#define XB_XGEN(j)  (2304 + 64 * (j))
#define XB_TOP      3328
#define XB_TOPGEN   3392
#define XCD_BAR_WORDS 3456
#define XB_SPIN_CAP (1u << 18)
__device__ __forceinline__ unsigned xb_ld(unsigned* p)              { return __hip_atomic_load(p, __ATOMIC_RELAXED, __HIP_MEMORY_SCOPE_AGENT); }
__device__ __forceinline__ unsigned xb_add(unsigned* p, unsigned v) { return __hip_atomic_fetch_add(p, v, __ATOMIC_RELAXED, __HIP_MEMORY_SCOPE_AGENT); }
__device__ __forceinline__ unsigned xb_xcc_id() { return (unsigned)__builtin_amdgcn_s_getreg((3 << 11) | 20) & 0xFu; }
#define XB_SPIN(cond, bar) do { unsigned _sp = 0; while (cond) { __builtin_amdgcn_s_sleep(1); \
    if ((++_sp & 255u) == 0u) { if (xb_ld(&(bar)[XB_TMO])) break; if (_sp > XB_SPIN_CAP) { atomicAdd(&(bar)[XB_TMO], 1u); break; } } } } while (0)
struct XcdBarrier { unsigned* bar; unsigned x; volatile LAS unsigned* st; };
__device__ __forceinline__ XcdBarrier xcd_barrier_post(unsigned* bar, volatile LAS unsigned* st) {
    XcdBarrier b; b.bar = bar; b.x = xb_xcc_id(); b.st = st;
    if (threadIdx.x == 0) (void)xb_add(&bar[XB_XCNT(b.x)], 1u);
    return b;
}
__device__ __forceinline__ void xcd_barrier_complete(unsigned* bar, unsigned x, unsigned& nloc, unsigned& nx) {
    const unsigned G = gridDim.x * gridDim.y * gridDim.z;
    unsigned sum, cnt, mine, sp = 0u;
    for (;;) {
        sum = 0u; cnt = 0u; mine = 0u;
#pragma unroll
        for (unsigned j = 0; j < 16; ++j) { const unsigned c = xb_ld(&bar[XB_XCNT(j)]); sum += c; cnt += (c > 0u) ? 1u : 0u; mine = (j == x) ? c : mine; }
        if (sum == G) break;
        __builtin_amdgcn_s_sleep(1);
        if ((++sp & 255u) == 0u) { if (xb_ld(&bar[XB_TMO])) break; if (sp > XB_SPIN_CAP) { atomicAdd(&bar[XB_TMO], 1u); break; } }
    }
    nloc = mine > 0u ? mine : 1u; nx = cnt > 0u ? cnt : 1u;
}
__device__ __forceinline__ void xcd_barrier(const XcdBarrier& b) {
    asm volatile("s_waitcnt vmcnt(0)" ::: "memory");
    __syncthreads();
    if (threadIdx.x == 0) {
        unsigned* bar = b.bar;
        __builtin_amdgcn_s_waitcnt(0);
        unsigned nloc = b.st[0], nx = b.st[1];
        if (nloc == 0u) { xcd_barrier_complete(bar, b.x, nloc, nx); b.st[0] = nloc; b.st[1] = nx; }
        const unsigned old = xb_add(&bar[XB_XSUB(b.x)], 1u);
        const unsigned gen = old / nloc;
        if (old + 1u == (gen + 1u) * nloc) {
            __builtin_amdgcn_fence(__ATOMIC_RELEASE, "agent");
            asm volatile("s_waitcnt vmcnt(0)" ::: "memory");
            const unsigned og = xb_add(&bar[XB_TOP], 1u);
            const unsigned tg = og / nx;
            if (og + 1u == (tg + 1u) * nx) xb_add(&bar[XB_TOPGEN], 1u);
            else XB_SPIN(xb_ld(&bar[XB_TOPGEN]) == tg, bar);
            __builtin_amdgcn_fence(__ATOMIC_ACQUIRE, "agent");
            xb_add(&bar[XB_XGEN(b.x)], 1u);
            asm volatile("s_waitcnt vmcnt(0)" ::: "memory");
        } else {
            XB_SPIN(xb_ld(&bar[XB_XGEN(b.x)]) == gen, bar);
            __builtin_amdgcn_fence(__ATOMIC_ACQUIRE, "agent");
            asm volatile("s_waitcnt vmcnt(0)" ::: "memory");
        }
    }
    __syncthreads();
}

struct Frame {
    LAS unsigned char* lds;
    volatile LAS unsigned* MISC;
    gu32* ctl;
    int tid, lane, wave;
    int vcu, G;
    const float *x, *c, *w_ada, *b_ada, *g_pre_attn, *w_in, *g_q_a, *g_k_a, *g_ckv, *w_kv_b, *g_out_a, *g_out_b, *w_out, *g_post_attn, *g_pre_mlp, *w_mlp_in, *w_mlp_out, *g_post_mlp;
    float* out;
    float *mod, *tab, *ssqc, *ssqo, *ssqp, *ssqy;
    bf16 *Win_t, *Wkvb_t, *Wout_t, *W1_t, *W2_t;
    bf16 *XN, *QA, *KA, *VA, *QB, *CKV, *KPE, *KVB, *OCAT, *OPROJ, *ACT, *Y;
};

__device__ __forceinline__ int fresh_lane() { unsigned z = 0u; asm volatile("" : "+v"(z)); return (int)__builtin_amdgcn_mbcnt_hi(~0u, __builtin_amdgcn_mbcnt_lo(~0u, z)); }
#define PHASE_BEGIN() do { F.lane = fresh_lane(); F.tid = F.wave * 64 + F.lane; } while (0)
__device__ __forceinline__ float wave_sum(float v) {
#pragma unroll
    for (int o = 1; o < 64; o <<= 1) v += __shfl_xor(v, o);
    return v;
}

__device__ __forceinline__ void p0_gemv_item(Frame& F, int j) {
    LAS float* sact = (LAS float*)(F.lds);
    LAS float* red = (LAS float*)(F.lds + 32768);
    for (int i = F.tid; i < 4 * DM; i += NWAVES * 64) { const float v = F.c[i]; sact[i] = v / (1.0f + expf(-v)); }
    __syncthreads();
    const int n0 = 64 * j, rsub = F.lane >> 4, c4 = (F.lane & 15) * 4;
    const float* wp = F.w_ada + (size_t)(256 * F.wave + rsub) * NMODW + n0 + c4;
    f32x4 a0 = {0.f, 0.f, 0.f, 0.f}, a1 = a0, a2 = a0, a3 = a0;
#pragma unroll 8
    for (int i = 0; i < 64; ++i) {
        const f32x4 wv = *(const f32x4*)(wp + (size_t)i * 4 * NMODW);
        const int k = 256 * F.wave + 4 * i + rsub;
        a0 += sact[k] * wv; a1 += sact[DM + k] * wv; a2 += sact[2 * DM + k] * wv; a3 += sact[3 * DM + k] * wv;
    }
#pragma unroll
    for (int e = 0; e < 4; ++e) {
        a0[e] += __shfl_xor(a0[e], 16); a0[e] += __shfl_xor(a0[e], 32);
        a1[e] += __shfl_xor(a1[e], 16); a1[e] += __shfl_xor(a1[e], 32);
        a2[e] += __shfl_xor(a2[e], 16); a2[e] += __shfl_xor(a2[e], 32);
        a3[e] += __shfl_xor(a3[e], 16); a3[e] += __shfl_xor(a3[e], 32);
    }
    if (rsub == 0) {
#pragma unroll
        for (int e = 0; e < 4; ++e) { red[(F.wave * 4 + 0) * 64 + c4 + e] = a0[e]; red[(F.wave * 4 + 1) * 64 + c4 + e] = a1[e]; red[(F.wave * 4 + 2) * 64 + c4 + e] = a2[e]; red[(F.wave * 4 + 3) * 64 + c4 + e] = a3[e]; }
    }
    __syncthreads();
    if (F.tid < 256) { const int b = F.tid >> 6, n = F.tid & 63; float s = 0.f;
#pragma unroll
        for (int w = 0; w < 8; ++w) s += red[(w * 4 + b) * 64 + n];
        F.mod[b * NMODW + n0 + n] = s + F.b_ada[n0 + n]; }
    __syncthreads();
}
__device__ __forceinline__ void p0_transpose_item(const float* W, int K, int N, bf16* WT, const float* ks, LAS float* scr, int item, int lane) {
    const int nblk = N / 32, kb = item / nblk, nb = item % nblk, k0 = 64 * kb, n0 = 32 * nb;
#pragma unroll 8
    for (int i = 0; i < 32; ++i) { const int kk = 2 * i + (lane >> 5); float v = W[(size_t)(k0 + kk) * N + n0 + (lane & 31)]; if (ks) v *= ks[k0 + kk]; scr[kk * 33 + (lane & 31)] = v; }
    LDS_WAIT(); asm volatile("" ::: "memory");
    const int c = lane & 7;
#pragma unroll
    for (int j = 0; j < 4; ++j) { const int n = (lane >> 3) + 8 * j; const LAS float* s = scr + (8 * c) * 33 + n;
        v4u o; o.x = pk2(s[0 * 33], s[1 * 33]); o.y = pk2(s[2 * 33], s[3 * 33]); o.z = pk2(s[4 * 33], s[5 * 33]); o.w = pk2(s[6 * 33], s[7 * 33]);
        *(GAS v4u*)(WT + (size_t)(n0 + n) * K + k0 + 8 * c) = o; }
    LDS_WAIT(); asm volatile("" ::: "memory");
}
__device__ __forceinline__ void p0_prologue(Frame& F) {
    const int bid = blockIdx.x;
    const bool gemvwg = bid < 192;
    if (gemvwg) p0_gemv_item(F, bid);
    if (bid == (int)gridDim.x - 1) {
        for (int idx = F.tid; idx < 64 * 32; idx += NWAVES * 64) { const int p = idx >> 5, i = idx & 31; const float inv = powf(10000.0f, -(float)(2 * i) / 64.0f); const float ang = (float)p * inv;
            F.tab[idx] = cosf(ang); F.tab[2048 + idx] = sinf(ang); }
        for (int idx = F.tid; idx < 64 * 16; idx += NWAVES * 64) { const int p = idx >> 4, i = idx & 15; const float inv = powf(10000.0f, -(float)(2 * i) / 32.0f); const float ang = (float)p * inv;
            F.tab[4096 + idx] = cosf(ang); F.tab[5120 + idx] = sinf(ang); }
    }
    LAS float* scr = (LAS float*)(F.lds + RING_OFF + F.wave * 16384);
    constexpr int I_IN = (DM / 64) * (W_IN / 32), I_KVB = (512 / 64) * (2048 / 32), I_OUT = (DM / 64) * (DM / 32), I_1 = (DM / 64) * (DFF / 32), I_2 = (DFF / 64) * (DM / 32);
    constexpr int NITEMS = I_IN + I_KVB + I_OUT + I_1 + I_2;
    int it, stride, limit;
    if ((int)gridDim.x == 256) {
        if (gemvwg) { it = bid * 8 + F.wave; stride = 1536; limit = 13824; }
        else { it = 13824 + (bid - 192) * 8 + F.wave; stride = 512; limit = NITEMS; }
    } else { it = bid * 8 + F.wave; stride = (int)gridDim.x * 8; limit = NITEMS; }
    for (; it < limit; it += stride) {
        int r = it;
        if (r < I_IN) { p0_transpose_item(F.w_in, DM, W_IN, F.Win_t, nullptr, scr, r, F.lane); continue; } r -= I_IN;
        if (r < I_KVB) { p0_transpose_item(F.w_kv_b, 512, 2048, F.Wkvb_t, F.g_ckv, scr, r, F.lane); continue; } r -= I_KVB;
        if (r < I_OUT) { const int kb = r / (DM / 32); const float* ks = (kb < 16) ? F.g_out_a : (F.g_out_b - 1024);
            p0_transpose_item(F.w_out, DM, DM, F.Wout_t, ks, scr, r, F.lane); continue; } r -= I_OUT;
        if (r < I_1) { p0_transpose_item(F.w_mlp_in, DM, DFF, F.W1_t, nullptr, scr, r, F.lane); continue; } r -= I_1;
        p0_transpose_item(F.w_mlp_out, DFF, DM, F.W2_t, nullptr, scr, r, F.lane);
    }
}
__device__ __forceinline__ void p1_rows(Frame& F) {
    const int gw = F.vcu * NWAVES + F.wave, NGW = F.G * NWAVES;
    for (int m = gw; m < M; m += NGW) {
        const int b = m >> 11; const float* sh = F.mod + b * NMODW; const float* scp = sh + DM;
        const f32x4* xr = (const f32x4*)(F.x + (size_t)m * DM) + F.lane;
        f32x4 v[8]; float s = 0.f;
#pragma unroll
        for (int j = 0; j < 8; ++j) { v[j] = xr[64 * j]; s += (v[j][0] * v[j][0] + v[j][1] * v[j][1]) + (v[j][2] * v[j][2] + v[j][3] * v[j][3]); }
        const float inv = 1.0f / sqrtf(wave_sum(s) * (1.0f / DM) + EPS);
        v2u* o8 = (v2u*)(F.XN + (size_t)m * DM) + F.lane;
#pragma unroll
        for (int j = 0; j < 8; ++j) { const int k = 4 * F.lane + 256 * j;
            const f32x4 g = *(const f32x4*)(F.g_pre_attn + k), sc = *(const f32x4*)(scp + k), sf = *(const f32x4*)(sh + k);
            const f32x4 h = v[j] * inv * g * (1.0f + sc) + sf;
            v2u w; w.x = pk2(h[0], h[1]); w.y = pk2(h[2], h[3]); o8[64 * j] = w; }
    }
}
__device__ __forceinline__ void p6_rows(Frame& F) {
    const int gw = F.vcu * NWAVES + F.wave, NGW = F.G * NWAVES;
    for (int m = gw; m < M; m += NGW) {
        const int b = m >> 11; const float* md = F.mod + b * NMODW; const float* gt = md + 2 * DM; const float* shm = md + 3 * DM; const float* scm = md + 4 * DM;
        const float ps = (F.lane < 32) ? F.ssqp[(size_t)m * 32 + F.lane] : 0.f;
        const float invo = 1.0f / sqrtf(wave_sum(ps) * (1.0f / DM) + EPS);
        const f32x4* xr = (const f32x4*)(F.x + (size_t)m * DM) + F.lane;
        const v2u* pr = (const v2u*)(F.OPROJ + (size_t)m * DM) + F.lane;
        f32x4* orow = (f32x4*)(F.out + (size_t)m * DM) + F.lane;
        f32x4 v[8]; float s = 0.f;
#pragma unroll
        for (int j = 0; j < 8; ++j) { const int k = 4 * F.lane + 256 * j;
            const v2u w = pr[64 * j]; const f32x4 op = {bflo(w.x), bfhi(w.x), bflo(w.y), bfhi(w.y)};
            const f32x4 g = *(const f32x4*)(F.g_post_attn + k), gg = *(const f32x4*)(gt + k);
            v[j] = xr[64 * j] + gg * (op * invo * g);
            orow[64 * j] = v[j];
            s += (v[j][0] * v[j][0] + v[j][1] * v[j][1]) + (v[j][2] * v[j][2] + v[j][3] * v[j][3]); }
        const float inv = 1.0f / sqrtf(wave_sum(s) * (1.0f / DM) + EPS);
        v2u* o8 = (v2u*)(F.XN + (size_t)m * DM) + F.lane;
#pragma unroll
        for (int j = 0; j < 8; ++j) { const int k = 4 * F.lane + 256 * j;
            const f32x4 g = *(const f32x4*)(F.g_pre_mlp + k), sc = *(const f32x4*)(scm + k), sf = *(const f32x4*)(shm + k);
            const f32x4 h = v[j] * inv * g * (1.0f + sc) + sf;
            v2u w; w.x = pk2(h[0], h[1]); w.y = pk2(h[2], h[3]); o8[64 * j] = w; }
    }
}
__device__ __forceinline__ void p9_rows(Frame& F) {
    const int gw = F.vcu * NWAVES + F.wave, NGW = F.G * NWAVES;
    for (int m = gw; m < M; m += NGW) {
        const int b = m >> 11; const float* gt = F.mod + b * NMODW + 5 * DM;
        const float ps = (F.lane < 32) ? F.ssqy[(size_t)m * 32 + F.lane] : 0.f;
        const float invy = 1.0f / sqrtf(wave_sum(ps) * (1.0f / DM) + EPS);
        const v2u* yr = (const v2u*)(F.Y + (size_t)m * DM) + F.lane;
        f32x4* orow = (f32x4*)(F.out + (size_t)m * DM) + F.lane;
#pragma unroll
        for (int j = 0; j < 8; ++j) { const int k = 4 * F.lane + 256 * j;
            const v2u w = yr[64 * j]; const f32x4 yv = {bflo(w.x), bfhi(w.x), bflo(w.y), bfhi(w.y)};
            const f32x4 g = *(const f32x4*)(F.g_post_mlp + k), gg = *(const f32x4*)(gt + k);
            orow[64 * j] = orow[64 * j] + gg * (yv * invy * g); }
    }
}
__device__ __forceinline__ void rope8(float (&x)[8], int j, int prow, int pcol, const float* tab) {
    const int pos = (j & 4) ? pcol : prow, fi0 = 8 * (j & 1); const float sgn = (j & 2) ? 1.f : -1.f;
    const float* ct = tab + 4096 + pos * 16 + fi0; const float* st = tab + 5120 + pos * 16 + fi0;
#pragma unroll
    for (int e = 0; e < 8; ++e) { const float part = __shfl_xor(x[e], 2); x[e] = x[e] * ct[e] + sgn * part * st[e]; }
}
__device__ __forceinline__ void normrope16(float (&x)[16], int j, int prow, int pcol, const float* g, const float* tab) {
    float ss = 0.f;
#pragma unroll
    for (int e = 0; e < 16; ++e) ss += x[e] * x[e];
    ss += __shfl_xor(ss, 1); ss += __shfl_xor(ss, 2); ss += __shfl_xor(ss, 4);
    const float inv = 1.0f / sqrtf(ss * (1.0f / 128.0f) + EPS);
    const int pos = (j & 4) ? pcol : prow, fi0 = 16 * (j & 1); const float sgn = (j & 2) ? 1.f : -1.f;
    const float* ct = tab + pos * 32 + fi0; const float* st = tab + 2048 + pos * 32 + fi0;
#pragma unroll
    for (int e = 0; e < 16; ++e) x[e] = x[e] * inv * g[16 * j + e];
#pragma unroll
    for (int e = 0; e < 16; ++e) { const float part = __shfl_xor(x[e], 2); x[e] = x[e] * ct[e] + sgn * part * st[e]; }
}
__device__ __forceinline__ void p3_fixup_rows(Frame& F) {
    const int gw = F.vcu * NWAVES + F.wave, NGW = F.G * NWAVES; const int l = F.lane, j = l & 7;
    for (int m = gw; m < M; m += NGW) {
        const int t = m & (SEQ - 1), prow = t >> 6, pcol = t & 63;
        {
            v4u* p = (v4u*)(F.QA + (size_t)m * 1024 + 16 * l); const v4u w0 = p[0], w1 = p[1]; float x[16];
#pragma unroll
            for (int e = 0; e < 4; ++e) { x[2 * e] = bflo(w0[e]); x[2 * e + 1] = bfhi(w0[e]); x[8 + 2 * e] = bflo(w1[e]); x[8 + 2 * e + 1] = bfhi(w1[e]); }
            normrope16(x, j, prow, pcol, F.g_q_a, F.tab);
            v4u o0, o1;
#pragma unroll
            for (int e = 0; e < 4; ++e) { o0[e] = pk2(x[2 * e], x[2 * e + 1]); o1[e] = pk2(x[8 + 2 * e], x[8 + 2 * e + 1]); }
            p[0] = o0; p[1] = o1;
        }
        {
            v4u* p = (v4u*)(F.KA + (size_t)m * 256 + 16 * (l & 15)); const v4u w0 = p[0], w1 = p[1]; float x[16];
#pragma unroll
            for (int e = 0; e < 4; ++e) { x[2 * e] = bflo(w0[e]); x[2 * e + 1] = bfhi(w0[e]); x[8 + 2 * e] = bflo(w1[e]); x[8 + 2 * e + 1] = bfhi(w1[e]); }
            normrope16(x, j, prow, pcol, F.g_k_a, F.tab);
            v4u o0, o1;
#pragma unroll
            for (int e = 0; e < 4; ++e) { o0[e] = pk2(x[2 * e], x[2 * e + 1]); o1[e] = pk2(x[8 + 2 * e], x[8 + 2 * e + 1]); }
            if (l < 16) { p[0] = o0; p[1] = o1; }
        }
        {
            v4u* p = (v4u*)(F.QB + (size_t)m * 1536 + 192 * (l >> 3) + 128 + 8 * j); const v4u w = p[0]; float x[8];
#pragma unroll
            for (int e = 0; e < 4; ++e) { x[2 * e] = bflo(w[e]); x[2 * e + 1] = bfhi(w[e]); }
            rope8(x, j, prow, pcol, F.tab);
            v4u o;
#pragma unroll
            for (int e = 0; e < 4; ++e) o[e] = pk2(x[2 * e], x[2 * e + 1]);
            p[0] = o;
        }
        {
            v4u* p = (v4u*)(F.KPE + (size_t)m * 64 + 8 * j); const v4u w = p[0]; float x[8];
#pragma unroll
            for (int e = 0; e < 4; ++e) { x[2 * e] = bflo(w[e]); x[2 * e + 1] = bfhi(w[e]); }
            rope8(x, j, prow, pcol, F.tab);
            v4u o;
#pragma unroll
            for (int e = 0; e < 4; ++e) o[e] = pk2(x[2 * e], x[2 * e + 1]);
            if (l < 8) p[0] = o;
        }
    }
}

struct Args { const float* in[18]; float* out; unsigned char* ws; int ph_lo, ph_hi, li, pad; };
__global__ void __launch_bounds__(NWAVES * 64, 2) mk_fwd(Args args) {
    extern __shared__ __attribute__((aligned(16))) unsigned char lds[];
    Frame F;
    F.lds = (LAS unsigned char*)lds;
    F.MISC = (volatile LAS unsigned*)(F.lds + MISC_OFF);
    F.tid = threadIdx.x; F.lane = F.tid & 63; F.wave = __builtin_amdgcn_readfirstlane(F.tid >> 6);
    F.G = gridDim.x; { const int bx = blockIdx.x; F.vcu = (F.G % 8 == 0) ? (bx % 8) * (F.G / 8) + bx / 8 : bx; }
    unsigned char* ws = args.ws;
    F.ctl = (gu32*)(ws + WS_CTL);
    F.x = args.in[0]; F.c = args.in[1]; F.w_ada = args.in[2]; F.b_ada = args.in[3]; F.g_pre_attn = args.in[4]; F.w_in = args.in[5]; F.g_q_a = args.in[6]; F.g_k_a = args.in[7];
    F.g_ckv = args.in[8]; F.w_kv_b = args.in[9]; F.g_out_a = args.in[10]; F.g_out_b = args.in[11]; F.w_out = args.in[12]; F.g_post_attn = args.in[13]; F.g_pre_mlp = args.in[14];
    F.w_mlp_in = args.in[15]; F.w_mlp_out = args.in[16]; F.g_post_mlp = args.in[17]; F.out = args.out;
    F.mod = (float*)(ws + WS_MOD); F.tab = (float*)(ws + WS_TAB); F.ssqc = (float*)(ws + WS_SSQC); F.ssqo = (float*)(ws + WS_SSQO); F.ssqp = (float*)(ws + WS_SSQP); F.ssqy = (float*)(ws + WS_SSQY);
    F.Win_t = (bf16*)(ws + WS_WIN); F.Wkvb_t = (bf16*)(ws + WS_WKVB); F.Wout_t = (bf16*)(ws + WS_WOUT); F.W1_t = (bf16*)(ws + WS_W1); F.W2_t = (bf16*)(ws + WS_W2);
    F.XN = (bf16*)(ws + WS_XN); F.QA = (bf16*)(ws + WS_QA); F.KA = (bf16*)(ws + WS_KA); F.VA = (bf16*)(ws + WS_VA); F.QB = (bf16*)(ws + WS_QB); F.CKV = (bf16*)(ws + WS_CKV); F.KPE = (bf16*)(ws + WS_KPE);
    F.KVB = (bf16*)(ws + WS_KVB); F.OCAT = (bf16*)(ws + WS_OCAT); F.OPROJ = (bf16*)(ws + WS_OPROJ); F.ACT = (bf16*)(ws + WS_ACT); F.Y = (bf16*)(ws + WS_Y);
    for (int u = F.tid; u < (LDS_BYTES - LDSCTL_OFF) / 4; u += NWAVES * 64) ((LAS unsigned*)(F.lds + LDSCTL_OFF))[u] = 0u;
    __syncthreads();
    XcdBarrier bar; bar.bar = (unsigned*)(F.ctl + CW_BAR); bar.x = 0; bar.st = nullptr;
    if (N_LAUNCHES == 1 && MK_CG_SEAMS != 0x1ff) bar = xcd_barrier_post((unsigned*)(F.ctl + CW_BAR), F.MISC + 8);
    const int lo = args.ph_lo, hi = args.ph_hi;
#ifndef PHMASK
#define PHMASK 0x3ff
#endif
#define IN(k) (((PHMASK >> (k)) & 1) && lo <= (k) && (k) < hi)
#define BOTH(k) (IN(k) && IN((k) + 1))
#define SEAM(k) do { if (BOTH(k)) { if ((MK_CG_SEAMS >> (k)) & 1) cg::this_grid().sync(); else xcd_barrier(bar); } } while (0)
#ifndef PH_REP_MASK
#define PH_REP_MASK 0
#endif
#define REP(k) for (int rep_ = 0; rep_ < (((PH_REP_MASK >> (k)) & 1) ? 2 : 1); ++rep_)
#define REPSEAM(k) do { if (((PH_REP_MASK >> (k)) & 1) && rep_ == 0) xcd_barrier(bar); } while (0)

    if (IN(0)) { PHASE_BEGIN(); REP(0) { p0_prologue(F); REPSEAM(0); } SEAM(0); }
    if (IN(1)) { PHASE_BEGIN(); REP(1) { p1_rows(F); REPSEAM(1); } SEAM(1); }
    if (IN(2)) { PHASE_BEGIN();
        pg8::Gemm g{F.XN, F.Win_t, M, W_INP, DM}; pg8::StaticOrder S; S.init(M, W_INP, F.G, (int)blockIdx.x);
        pg8::EpiProj E{F.QA, F.KA, F.VA, F.QB, F.CKV, F.KPE, F.ssqc};
        REP(2) { pg8::gemm_phase<pg8::EpiProj, pg8::StaticOrder, PG8_ALIGN, PG8_SP2>(F.lds + RING_OFF, F.lds + TAB_OFF, g, S, E, F.tid, F.wave); REPSEAM(2); }
        SEAM(2);
    }
    if (IN(3)) { PHASE_BEGIN();
        pg8::Gemm g{F.CKV, F.Wkvb_t, M, 2048, 512}; pg8::StaticOrder S; S.init(M, 2048, F.G, (int)blockIdx.x);
        pg8::EpiKvb E{F.KVB, F.ssqc};
        pg8::gemm_phase<pg8::EpiKvb, pg8::StaticOrder, PG8_ALIGN, PG8_SP2>(F.lds + RING_OFF, F.lds + TAB_OFF, g, S, E, F.tid, F.wave);
        p3_fixup_rows(F);
        SEAM(3);
    }
    if (IN(4)) { PHASE_BEGIN();
        REP(4) { for (int u = F.vcu; u < 256; u += F.G) {
#ifndef ATT_SEL
#define ATT_SEL 3
#endif
            if (ATT_SEL & 1) {   const int pair = u >> 5, b = pair >> 1, kvh = pair & 1, r = u & 31, h = kvh * 4 + (r >> 3), qb = r & 7; const size_t row0 = (size_t)b * SEQ + qb * 256;
                attn::attn_unit<128, 2, 1024, 256, 256>(F.QA + row0 * 1024 + h * 128, F.KA + (size_t)b * SEQ * 256 + kvh * 128, nullptr, F.VA + (size_t)b * SEQ * 256 + kvh * 128,
                                                       F.OCAT + row0 * 2048 + h * 128, F.ssqo + row0 * 16 + h, SEQ, (char*)lds + RING_OFF, F.wave); }
            if (ATT_SEL & 2) {   const int pair = u >> 3, b = pair >> 3, h = pair & 7, qb = u & 7; const size_t row0 = (size_t)b * SEQ + qb * 256;
                attn::attn_unit<192, 1, 1536, 2048, 2048>(F.QB + row0 * 1536 + h * 192, F.KVB + (size_t)b * SEQ * 2048 + h * 256, F.KPE + (size_t)b * SEQ * 64, F.KVB + (size_t)b * SEQ * 2048 + h * 256 + 128,
                                                         F.OCAT + row0 * 2048 + 1024 + h * 128, F.ssqo + row0 * 16 + 8 + h, SEQ, (char*)lds + RING_OFF, F.wave); }
        } REPSEAM(4); }
        SEAM(4);
    }
    if (IN(5)) { PHASE_BEGIN();
        pg8::StaticOrder S; S.init(M, DM, F.G, (int)blockIdx.x);
        pg8::Unit u0; if (S.next(0, u0)) {
            if (F.tid < 256) { const float* sp = F.ssqo + (size_t)(u0.pm * 256 + F.tid) * 16;
                const f32x4 a0 = *(const f32x4*)sp, a1 = *(const f32x4*)(sp + 4), b0 = *(const f32x4*)(sp + 8), b1 = *(const f32x4*)(sp + 12);
                const float sa = ((a0[0] + a0[1]) + (a0[2] + a0[3])) + ((a1[0] + a1[1]) + (a1[2] + a1[3])), sb = ((b0[0] + b0[1]) + (b0[2] + b0[3])) + ((b1[0] + b1[1]) + (b1[2] + b1[3]));
                const float ra = 1.0f / sqrtf(sa * (1.0f / 1024.0f) + EPS), rb = 1.0f / sqrtf(sb * (1.0f / 1024.0f) + EPS);
                LAS float* T = (LAS float*)(F.lds + TAB_OFF); T[F.tid] = ra / rb; T[256 + F.tid] = rb; }
        }
        __syncthreads();
        pg8::Gemm g{F.OCAT, F.Wout_t, M, DM, DM};
        pg8::EpiGen<0, true, true> E{F.OPROJ, DM, F.ssqp, 32};
        REP(5) { pg8::gemm_phase<pg8::EpiGen<0, true, true>, pg8::StaticOrder, PG8_ALIGN, PG8_SP2>(F.lds + RING_OFF, F.lds + TAB_OFF, g, S, E, F.tid, F.wave); REPSEAM(5); }
        SEAM(5);
    }
    if (IN(6)) { PHASE_BEGIN(); REP(6) { p6_rows(F); REPSEAM(6); } SEAM(6); }
    if (IN(7)) { PHASE_BEGIN();
        pg8::Gemm g{F.XN, F.W1_t, M, DFF, DM}; pg8::StaticOrder S; S.init(M, DFF, F.G, (int)blockIdx.x);
        pg8::EpiGen<1, false, false> E{F.ACT, DFF, nullptr, 0};
        REP(7) { pg8::gemm_phase<pg8::EpiGen<1, false, false>, pg8::StaticOrder, PG8_ALIGN, PG8_SP2>(F.lds + RING_OFF, F.lds + TAB_OFF, g, S, E, F.tid, F.wave); REPSEAM(7); }
        SEAM(7);
    }
    if (IN(8)) { PHASE_BEGIN();
        pg8::Gemm g{F.ACT, F.W2_t, M, DM, DFF}; pg8::StaticOrder S; S.init(M, DM, F.G, (int)blockIdx.x);
        pg8::EpiGen<0, false, true> E{F.Y, DM, F.ssqy, 32};
        REP(8) { pg8::gemm_phase<pg8::EpiGen<0, false, true>, pg8::StaticOrder, PG8_ALIGN, PG8_SP2>(F.lds + RING_OFF, F.lds + TAB_OFF, g, S, E, F.tid, F.wave); REPSEAM(8); }
        SEAM(8);
    }
    if (IN(9)) { PHASE_BEGIN(); p9_rows(F); }
#undef IN
#undef BOTH
#undef SEAM
}

extern "C" void kernel_launch(void* const* d_in, const int* in_sizes, int n_in, void* d_out, int out_size, void* d_ws, size_t ws_size, hipStream_t stream) {
    static int grid = 0;
    if (grid == 0) {
        if (n_in != 18 || in_sizes[0] != M * DM || out_size != M * DM || ws_size < WS_END) { fprintf(stderr, "kernel_launch: shape/workspace mismatch (n_in %d, in0 %d, out %d, ws %zu)\n", n_in, n_in > 0 ? in_sizes[0] : -1, out_size, ws_size); grid = -1; return; }
        int dev = 0, cus = 0, per_cu = 0;
        if (hipGetDevice(&dev) != hipSuccess || hipDeviceGetAttribute(&cus, hipDeviceAttributeMultiprocessorCount, dev) != hipSuccess) { grid = -1; return; }
        if (hipFuncSetAttribute((const void*)mk_fwd, hipFuncAttributeMaxDynamicSharedMemorySize, LDS_BYTES) != hipSuccess) { fprintf(stderr, "kernel_launch: hipFuncSetAttribute failed\n"); grid = -1; return; }
        if (hipOccupancyMaxActiveBlocksPerMultiprocessor(&per_cu, (const void*)mk_fwd, NWAVES * 64, LDS_BYTES) != hipSuccess || per_cu < 1) { fprintf(stderr, "kernel_launch: occupancy query says %d blocks/CU\n", per_cu); per_cu = 1; }
        (void)hipGetLastError();
        grid = cus;
        if (grid != 256) fprintf(stderr, "kernel_launch: %d CUs (tuned for 256)\n", grid);
    }
    if (grid < 0) return;
    (void)hipMemsetAsync((char*)d_ws + WS_CTL, 0, CTL_ZERO_BYTES, stream);
    Args a{};
    for (int i = 0; i < 18; ++i) a.in[i] = (const float*)d_in[i];
    a.out = (float*)d_out; a.ws = (unsigned char*)d_ws;
    if (N_LAUNCHES == 1) {
        a.ph_lo = 0; a.ph_hi = PER_PHASE; a.li = 0;
        void* kargs[] = {&a};
        const hipError_t e = hipLaunchCooperativeKernel((const void*)mk_fwd, dim3(grid), dim3(NWAVES * 64), kargs, LDS_BYTES, stream);
        if (e != hipSuccess) fprintf(stderr, "kernel_launch: cooperative launch failed: %s (grid %d)\n", hipGetErrorString(e), grid);
    } else {
        for (int li = 0; li < PER_PHASE; ++li) {
            a.ph_lo = li; a.ph_hi = li + 1; a.li = li;
            hipLaunchKernelGGL(mk_fwd, dim3(grid), dim3(NWAVES * 64), LDS_BYTES, stream, a);
        }
        const hipError_t le = hipPeekAtLastError();
        if (le != hipSuccess) fprintf(stderr, "kernel_launch: launch failed: %s\n", hipGetErrorName(le));
    }
}
```
